# Optimizing an MI355X kernel written in HIP

```python
import jax
import jax.numpy as jnp
from jax import lax
import numpy as np

D_MODEL = 2048
BATCH = 1
SEQ = 16384
DEPTH = 2

D_BRANCH = 1024
N_BRANCH = 3
D_A = D_BRANCH
H_A = 16
BW_A = D_A // H_A
CONV_W = 4
LRU_C = 8.0
DH_B = 128
H_B = D_BRANCH // DH_B
D_B = H_B * DH_B
Q_BLOCK = 128
N_C = 64
H_C = D_BRANCH // N_C
D_C = H_C * N_C
LORA_W = 64
LORA_A = 64
N_SHIFT = 3 * D_C + LORA_W + LORA_A
NORM_EPS = 1e-6
GN_EPS = 64e-5
COL_A = 2 * D_A
COL_B = 4 * D_B + H_B
COL_GATE_C = D_C
COL_MERGE = N_BRANCH * D_MODEL
N_IN = COL_A + COL_B + N_SHIFT + COL_GATE_C + COL_MERGE

kernel_name = 'hybrid_rglru_fox_rwkv7_block'


def _rmsnorm(x, g):
    xf = x.astype(jnp.float32)
    y = xf * lax.rsqrt(jnp.mean(xf * xf, -1, keepdims=True) + NORM_EPS)
    return (y * g.astype(jnp.float32)).astype(x.dtype)


def _split(p, sizes):
    out, off = [], 0
    for s in sizes:
        out.append(p[..., off:off + s])
        off += s
    return out


def _rglru_branch(xa, ga, conv_w, conv_b, gate_w, gate_b, lam):
    f32 = jnp.float32
    B, S, _ = xa.shape
    xc = lax.conv_general_dilated(xa, conv_w[:, None, :], window_strides=(1,), padding=[(CONV_W - 1, 0)],
                                  dimension_numbers=('NWC', 'WIO', 'NWC'), feature_group_count=D_A) + conv_b
    xb = xc.reshape(B, S, H_A, BW_A)
    gates = jnp.einsum('bshi,ghij->gbshj', xb, gate_w).reshape(2, B, S, D_A) + gate_b[:, None, None, :]
    r = jax.nn.sigmoid(gates[0].astype(f32))
    i = jax.nn.sigmoid(gates[1].astype(f32))
    log_a = -LRU_C * r * jax.nn.softplus(-lam.astype(f32))
    a = jnp.exp(log_a)
    mult = jnp.sqrt(-jnp.expm1(2.0 * log_a))
    mult = jnp.where((jnp.arange(S) == 0)[None, :, None], 1.0, mult)
    b = mult * i * xc.astype(f32)

    def combine(lhs, rhs):
        a1, b1 = lhs
        a2, b2 = rhs
        return a1 * a2, a2 * b1 + b2

    _, h = lax.associative_scan(combine, (a, b), axis=1)
    return h.astype(xa.dtype) * jax.nn.silu(ga)


def _fox_branch(q, k, v, f_logit, gb, b_f):
    f32 = jnp.float32
    B, S, _ = q.shape
    nb = S // Q_BLOCK
    qh = (q.astype(f32) * DH_B ** -0.5).reshape(B, S, H_B, DH_B)
    kh = k.astype(f32).reshape(B, S, H_B, DH_B)
    vh = v.astype(f32).reshape(B, S, H_B, DH_B)
    c = jnp.cumsum(jax.nn.log_sigmoid(f_logit.astype(f32) + b_f.astype(f32)), axis=1)
    c_bhs = jnp.transpose(c, (0, 2, 1))
    q_blocks = jnp.transpose(qh.reshape(B, nb, Q_BLOCK, H_B, DH_B), (1, 0, 2, 3, 4))
    c_blocks = jnp.transpose(c.reshape(B, nb, Q_BLOCK, H_B), (1, 0, 3, 2))
    k_pos = jnp.arange(S)

    def block(args):
        qb, cb, bi = args
        q_pos = bi * Q_BLOCK + jnp.arange(Q_BLOCK)
        s = jnp.einsum('bqhd,bkhd->bhqk', qb, kh)
        s = s + cb[..., :, None] - c_bhs[:, :, None, :]
        s = jnp.where(k_pos[None, :] <= q_pos[:, None], s, -jnp.inf)
        p = jax.nn.softmax(s, axis=-1)
        return jnp.einsum('bhqk,bkhd->bqhd', p, vh)

    o = lax.map(block, (q_blocks, c_blocks, jnp.arange(nb)))
    o = jnp.transpose(o, (1, 0, 2, 3, 4)).reshape(B, S, D_B)
    return o.astype(q.dtype) * jax.nn.silu(gb)


def _rwkv7_branch(cr, ck, cv, cwd, cad, gc, w0, w_up, a0, a_up, k_k, k_a, r_k, ln_w, ln_b):
    f32 = jnp.float32
    B, S, _ = cr.shape
    heads = lambda t: t.reshape(B, S, H_C, N_C)
    w_log = -jax.nn.softplus(-(w0 + jnp.tanh(cwd) @ w_up).astype(f32)) - 0.5
    decay = jnp.exp(-jnp.exp(w_log))
    a = jax.nn.sigmoid((a0 + cad @ a_up).astype(f32))
    k = ck.astype(f32)
    kk = heads(k * k_k.astype(f32))
    kk = kk * lax.rsqrt(jnp.maximum(jnp.sum(kk * kk, -1, keepdims=True), 1e-24))
    k = heads(k * (1.0 + (a - 1.0) * k_a.astype(f32)))
    r = heads(cr.astype(f32))
    v = heads(cv.astype(f32))
    decay = heads(decay)
    a = heads(a)

    def step(state, inp):
        r_t, w_t, k_t, v_t, kk_t, a_t = inp
        sa = jnp.einsum('bhvk,bhk->bhv', state, -kk_t)
        state = (state * w_t[:, :, None, :] + sa[..., None] * (kk_t * a_t)[:, :, None, :]
                 + v_t[..., None] * k_t[:, :, None, :])
        return state, jnp.einsum('bhvk,bhk->bhv', state, r_t)

    xs = tuple(jnp.swapaxes(t, 0, 1) for t in (r, decay, k, v, kk, a))
    state0 = jnp.zeros((B, H_C, N_C, N_C), f32)
    _, y = lax.scan(step, state0, xs)
    y = jnp.swapaxes(y, 0, 1)
    mu = jnp.mean(y, -1, keepdims=True)
    var = jnp.mean(jnp.square(y - mu), -1, keepdims=True)
    y = ((y - mu) * lax.rsqrt(var + GN_EPS)).reshape(B, S, D_C) * ln_w.astype(f32) + ln_b.astype(f32)
    bonus = jnp.sum(r * k * r_k.astype(f32), -1, keepdims=True) * v
    y = y + bonus.reshape(B, S, D_C)
    return y.astype(gc.dtype) * jax.nn.silu(gc)


def setup_inputs(seed: int = 0) -> dict:
    key = jax.random.key(seed)
    ks = jax.random.split(key, 24)
    f32 = jnp.float32
    nrm = lambda k, shape, scale: jax.random.normal(k, shape, f32) * scale
    x = nrm(ks[0], (BATCH, SEQ, D_MODEL), 1.0)
    pre_norm_w = 1.0 + nrm(ks[1], (DEPTH, D_MODEL), 0.02)
    post_norm_w = 1.0 + nrm(ks[2], (DEPTH, D_MODEL), 0.02)
    w_in = nrm(ks[3], (DEPTH, D_MODEL, N_IN), D_MODEL ** -0.5)
    b_merge = nrm(ks[4], (DEPTH, N_BRANCH, D_MODEL), 0.02)
    conv_w = nrm(ks[5], (DEPTH, CONV_W, D_A), CONV_W ** -0.5)
    conv_b = nrm(ks[6], (DEPTH, D_A), 0.02)
    lru_gate_w = nrm(ks[7], (DEPTH, 2, H_A, BW_A, BW_A), BW_A ** -0.5)
    lru_gate_b = nrm(ks[8], (DEPTH, 2, D_A), 0.02)
    u = jax.random.uniform(ks[9], (DEPTH, D_A), f32, 0.9, 0.999)
    p = u ** (1.0 / LRU_C)
    lru_lambda = jnp.log(p) - jnp.log1p(-p)
    fox_b_f = jax.random.uniform(ks[10], (DEPTH, H_B), f32, 1.0, 4.0)
    rwkv_mu = jax.random.uniform(ks[11], (DEPTH, N_SHIFT), f32, 0.0, 1.0)
    rwkv_w0 = jax.random.uniform(ks[12], (DEPTH, D_C), f32, -6.0, -1.0)
    rwkv_w_up = nrm(ks[13], (DEPTH, LORA_W, D_C), 0.5 * LORA_W ** -0.5)
    rwkv_a0 = nrm(ks[14], (DEPTH, D_C), 0.1)
    rwkv_a_up = nrm(ks[15], (DEPTH, LORA_A, D_C), LORA_A ** -0.5)
    rwkv_k_k = 0.85 + nrm(ks[16], (DEPTH, D_C), 0.02)
    rwkv_k_a = 1.0 + nrm(ks[17], (DEPTH, D_C), 0.02)
    rwkv_r_k = nrm(ks[18], (DEPTH, H_C, N_C), 0.1)
    rwkv_ln_w = 1.0 + nrm(ks[19], (DEPTH, D_C), 0.02)
    rwkv_ln_b = nrm(ks[20], (DEPTH, D_C), 0.02)
    w_branch = nrm(ks[21], (DEPTH, N_BRANCH, D_BRANCH, D_MODEL), D_BRANCH ** -0.5)
    w_out = nrm(ks[22], (DEPTH, D_MODEL, D_MODEL), D_MODEL ** -0.5)
    return {'x': x, 'pre_norm_w': pre_norm_w, 'post_norm_w': post_norm_w, 'w_in': w_in, 'b_merge': b_merge,
            'conv_w': conv_w, 'conv_b': conv_b, 'lru_gate_w': lru_gate_w, 'lru_gate_b': lru_gate_b,
            'lru_lambda': lru_lambda, 'fox_b_f': fox_b_f, 'rwkv_mu': rwkv_mu, 'rwkv_w0': rwkv_w0,
            'rwkv_w_up': rwkv_w_up, 'rwkv_a0': rwkv_a0, 'rwkv_a_up': rwkv_a_up, 'rwkv_k_k': rwkv_k_k,
            'rwkv_k_a': rwkv_k_a, 'rwkv_r_k': rwkv_r_k, 'rwkv_ln_w': rwkv_ln_w, 'rwkv_ln_b': rwkv_ln_b,
            'w_branch': w_branch, 'w_out': w_out}


def reference(x, pre_norm_w, post_norm_w, w_in, b_merge, conv_w, conv_b, lru_gate_w, lru_gate_b, lru_lambda,
              fox_b_f, rwkv_mu, rwkv_w0, rwkv_w_up, rwkv_a0, rwkv_a_up, rwkv_k_k, rwkv_k_a, rwkv_r_k,
              rwkv_ln_w, rwkv_ln_b, w_branch, w_out):
    B, S, _ = x.shape
    for l in range(DEPTH):
        h = _rmsnorm(x, pre_norm_w[l])
        p = h @ w_in[l]
        pa, pb, pc, gc, mg = _split(p, (COL_A, COL_B, N_SHIFT, COL_GATE_C, COL_MERGE))
        xa, ga = _split(pa, (D_A, D_A))
        q, k, v, fl, gb = _split(pb, (D_B, D_B, D_B, H_B, D_B))
        pc_prev = jnp.pad(pc, ((0, 0), (1, 0), (0, 0)))[:, :-1]
        pc = pc + (pc_prev - pc) * rwkv_mu[l]
        cr, ck, cv, cwd, cad = _split(pc, (D_C, D_C, D_C, LORA_W, LORA_A))
        ya = _rglru_branch(xa, ga, conv_w[l], conv_b[l], lru_gate_w[l], lru_gate_b[l], lru_lambda[l])
        yb = _fox_branch(q, k, v, fl, gb, fox_b_f[l])
        yc = _rwkv7_branch(cr, ck, cv, cwd, cad, gc, rwkv_w0[l], rwkv_w_up[l], rwkv_a0[l], rwkv_a_up[l],
                           rwkv_k_k[l], rwkv_k_a[l], rwkv_r_k[l], rwkv_ln_w[l], rwkv_ln_b[l])
        g = jax.nn.sigmoid(mg.reshape(B, S, N_BRANCH, D_MODEL) + b_merge[l])
        m = (g[:, :, 0] * (ya @ w_branch[l, 0]) + g[:, :, 1] * (yb @ w_branch[l, 1])
             + g[:, :, 2] * (yc @ w_branch[l, 2]))
        x = x + _rmsnorm(m @ w_out[l], post_norm_w[l])
    return x
```

```cpp
#include <hip/hip_runtime.h>
#include <hip/hip_cooperative_groups.h>
#include <cstdio>
#include <cstdint>
namespace cg = cooperative_groups;

#define LAS __attribute__((address_space(3)))
typedef unsigned short bf16_t;
typedef short bf16x8 __attribute__((ext_vector_type(8)));
typedef float f32x2 __attribute__((ext_vector_type(2)));
typedef float f32x4 __attribute__((ext_vector_type(4)));
typedef float f32x16 __attribute__((ext_vector_type(16)));
typedef unsigned u32x2 __attribute__((ext_vector_type(2)));
typedef unsigned u32x4 __attribute__((ext_vector_type(4)));

constexpr int S_ = 16384, DM = 2048, NP = 16640, NIN = 16520, DBR = 1024;
constexpr int COL_PC = 0, COL_FL = 3200, COL_GC = 3328, COL_XA = 4352, COL_GA = 5376, COL_Q = 6400, COL_K = 7424, COL_V = 8448, COL_GB = 9472, COL_MG = 10496;
constexpr int NA = 3328;
constexpr float NORM_EPS = 1e-6f, GN_EPS = 64e-5f, LOG2E = 1.4426950408889634f;
constexpr int LDS_BYTES = 147456;
constexpr int N_RWKV_BLK = 64;

constexpr size_t OFF_CTL = 0, CTL_BYTES = 1u << 20;
constexpr size_t OFF_P = CTL_BYTES;
constexpr size_t SZ_P = (size_t)S_ * NP * 2;
constexpr size_t OFF_WIN = OFF_P + SZ_P;
constexpr size_t SZ_WIN = (size_t)NP * DM * 2;
constexpr size_t OFF_VT = OFF_WIN;
constexpr size_t OFF_C = OFF_WIN + (size_t)8 * 128 * S_ * 2;
constexpr size_t OFF_WSM = OFF_WIN + SZ_WIN;
constexpr size_t SZ_WBR = (size_t)3 * DM * DBR * 2, SZ_WOUT = (size_t)DM * DM * 2, SZ_WGT = (size_t)2 * 16 * 64 * 64 * 2;
constexpr size_t SZ_WLORA = (size_t)2 * DBR * 64 * 2;
constexpr size_t SZ_WSM_L = SZ_WBR + SZ_WOUT + SZ_WGT + SZ_WLORA;
constexpr size_t OFF_HY = OFF_WSM + 2 * SZ_WSM_L;
constexpr size_t SZ_Y1 = (size_t)S_ * DBR * 2;
constexpr size_t OFF_RW = OFF_HY + 3 * SZ_Y1;
constexpr size_t SZ_DEC = (size_t)S_ * DBR * 4;
constexpr size_t OFF_M = OFF_RW, OFF_MO = OFF_RW + (size_t)S_ * DM * 2;
constexpr size_t OFF_BON = OFF_RW + SZ_DEC + 5 * SZ_Y1;
constexpr size_t OFF_YRAW = OFF_BON + (size_t)S_ * 16 * 4;
constexpr size_t OFF_AGA = OFF_YRAW + (size_t)S_ * DBR * 4;
constexpr size_t OFF_AGB = OFF_AGA + (1u << 20);
constexpr size_t OFF_CIN = OFF_AGB + (1u << 20);
constexpr size_t OFF_TS = OFF_CIN + (1u << 20);
constexpr size_t WS_END = OFF_TS + (1u << 16);
constexpr size_t OFF_ACUM = OFF_C + (size_t)8 * S_ * 4;
static_assert(OFF_ACUM + (size_t)S_ * DBR * 2 <= OFF_WSM, "ACUM fits behind VT and C");
constexpr int CW_ATTN = 0;
constexpr int CW_ROWSS = 4096;
constexpr int CW_KN = 3072;
constexpr int CW_PB = 2048;

__device__ __forceinline__ float bf2f(unsigned b) { return __uint_as_float(b << 16); }
__device__ __forceinline__ float bflo(unsigned w) { return __uint_as_float(w << 16); }
__device__ __forceinline__ float bfhi(unsigned w) { return __uint_as_float(w & 0xffff0000u); }
__device__ __forceinline__ unsigned f2bf(float f) { unsigned u = __float_as_uint(f); return (u + 0x7fffu + ((u >> 16) & 1u)) >> 16; }
__device__ __forceinline__ unsigned pk2(float lo, float hi) { return f2bf(lo) | (f2bf(hi) << 16); }
__device__ __forceinline__ unsigned cvt_pk_bf16(float lo, float hi) { unsigned r; asm volatile("v_cvt_pk_bf16_f32 %0, %1, %2" : "=v"(r) : "v"(lo), "v"(hi)); return r; }
__device__ __forceinline__ float sigmoidf_(float x) { return 1.0f / (1.0f + __expf(-x)); }
__device__ __forceinline__ float siluf_(float x) { return x / (1.0f + __expf(-x)); }
__device__ __forceinline__ float softplusf_(float x) { return fmaxf(x, 0.f) + log1pf(expf(-fabsf(x))); }
__device__ __forceinline__ float logsigf_(float x) { return fminf(x, 0.f) - log1pf(expf(-fabsf(x))); }
__device__ __forceinline__ int fresh_tid() { int t = threadIdx.x; asm volatile("" : "+v"(t)); return t; }
#define LDS_WAIT() asm volatile("s_waitcnt lgkmcnt(0)" ::: "memory")
template <int CTRL> __device__ __forceinline__ float dppf(float x) { return __int_as_float(__builtin_amdgcn_update_dpp(0, __float_as_int(x), CTRL, 0xf, 0xf, true)); }
__device__ __forceinline__ float rowsum16(float x) {
    x += dppf<0xB1>(x); x += dppf<0x4E>(x); x += dppf<0x141>(x); x += dppf<0x140>(x); return x;
}

__device__ __forceinline__ float wave_sum(float v) { v = rowsum16(v); v += __shfl_xor(v, 16); v += __shfl_xor(v, 32); return v; }

__device__ __forceinline__ void part_barrier(unsigned* ctr, unsigned target) {
    asm volatile("s_waitcnt vmcnt(0)" ::: "memory");
    __syncthreads();
    if (threadIdx.x == 0) {
        __threadfence();
        __hip_atomic_fetch_add(ctr, 1u, __ATOMIC_RELEASE, __HIP_MEMORY_SCOPE_AGENT);
        while (__hip_atomic_load(ctr, __ATOMIC_ACQUIRE, __HIP_MEMORY_SCOPE_AGENT) < target) __builtin_amdgcn_s_sleep(2);
        __threadfence();
    }
    __syncthreads();
}
__device__ __forceinline__ void part_wait(unsigned* ctr, unsigned target) {
    __syncthreads();
    if (threadIdx.x == 0) { while (__hip_atomic_load(ctr, __ATOMIC_ACQUIRE, __HIP_MEMORY_SCOPE_AGENT) < target) __builtin_amdgcn_s_sleep(2); __threadfence(); }
    __syncthreads();
}


#define XB_TMO      128
#define XB_XCNT(j)  (256  + 64 * (j))
#define XB_XSUB(j)  (1280 + 64 * (j))
#define XB_XGEN(j)  (2304 + 64 * (j))
#define XB_TOP      3328
#define XB_TOPGEN   3392
#define XCD_BAR_WORDS 3456
#define XB_SPIN_CAP (1u << 22)
__device__ __forceinline__ unsigned xb_ld(unsigned* p)              { return __hip_atomic_load(p, __ATOMIC_RELAXED, __HIP_MEMORY_SCOPE_AGENT); }
__device__ __forceinline__ unsigned xb_add(unsigned* p, unsigned v) { return __hip_atomic_fetch_add(p, v, __ATOMIC_RELAXED, __HIP_MEMORY_SCOPE_AGENT); }
__device__ __forceinline__ unsigned xb_xcc_id() { return (unsigned)__builtin_amdgcn_s_getreg((3 << 11) | 20) & 0xFu; }
#define XB_SPIN(cond, bar) do { unsigned _sp = 0; while (cond) { __builtin_amdgcn_s_sleep(1); \
    if ((++_sp & 255u) == 0u) { if (xb_ld(&(bar)[XB_TMO])) break; if (_sp > XB_SPIN_CAP) { atomicAdd(&(bar)[XB_TMO], 1u); break; } } } } while (0)
struct XcdBarrier { unsigned* bar; unsigned x; volatile LAS unsigned* st; };
__device__ __forceinline__ void xcd_barrier_complete(unsigned* bar, unsigned x, unsigned& nloc, unsigned& nx) {
    const unsigned G = gridDim.x * gridDim.y * gridDim.z;
    unsigned sum, cnt, mine, sp = 0u;
    for (;;) {
        sum = 0u; cnt = 0u; mine = 0u;
#pragma unroll
        for (unsigned j = 0; j < 16; ++j) { const unsigned c = xb_ld(&bar[XB_XCNT(j)]); sum += c; cnt += (c > 0u) ? 1u : 0u; mine = (j == x) ? c : mine; }
        if (sum == G) break;
        __builtin_amdgcn_s_sleep(1);
        if ((++sp & 255u) == 0u) { if (xb_ld(&bar[XB_TMO])) break; if (sp > XB_SPIN_CAP) { atomicAdd(&bar[XB_TMO], 1u); break; } }
    }
    nloc = mine > 0u ? mine : 1u; nx = cnt > 0u ? cnt : 1u;
}
__device__ __forceinline__ void xcd_barrier(const XcdBarrier& b) {
    asm volatile("s_waitcnt vmcnt(0)" ::: "memory");
    __syncthreads();
    if (threadIdx.x == 0) {
        unsigned* bar = b.bar;
        __builtin_amdgcn_s_waitcnt(0);
        unsigned nloc = b.st[0], nx = b.st[1];
        if (nloc == 0u) { xcd_barrier_complete(bar, b.x, nloc, nx); b.st[0] = nloc; b.st[1] = nx; }
        const unsigned old = xb_add(&bar[XB_XSUB(b.x)], 1u);
        const unsigned gen = old / nloc;
        if (old + 1u == (gen + 1u) * nloc) {
            __builtin_amdgcn_fence(__ATOMIC_RELEASE, "agent");
            asm volatile("s_waitcnt vmcnt(0)" ::: "memory");
            const unsigned og = xb_add(&bar[XB_TOP], 1u);
            const unsigned tg = og / nx;
            if (og + 1u == (tg + 1u) * nx) xb_add(&bar[XB_TOPGEN], 1u);
            else XB_SPIN(xb_ld(&bar[XB_TOPGEN]) == tg, bar);
            __builtin_amdgcn_fence(__ATOMIC_ACQUIRE, "agent");
            xb_add(&bar[XB_XGEN(b.x)], 1u);
            asm volatile("s_waitcnt vmcnt(0)" ::: "memory");
        } else {
            XB_SPIN(xb_ld(&bar[XB_XGEN(b.x)]) == gen, bar);
            __builtin_amdgcn_fence(__ATOMIC_ACQUIRE, "agent");
            asm volatile("s_waitcnt vmcnt(0)" ::: "memory");
        }
    }
    __syncthreads();
}
constexpr int CW_XBAR = 40960;
constexpr int XB_ST_OFF = 144 * 1024 - 32;

namespace pg8 {
constexpr int BM = 256, BK = 64, HALF = 128, HTB = HALF * BK * 2, STAGE_BYTES = 8 * HTB, NXCD = 8, WGM = 8;
__host__ __device__ __forceinline__ int lds_byte(int r, int c) { const int st = (r >> 4) * 2 + (c >> 5), rr = r & 15, cc = c & 31, ob = rr * 64 + cc * 2; return st * 1024 + (ob ^ (((ob >> 9) & 1) << 5)); }
__host__ __device__ __forceinline__ void stage_rc(int b, int& R, int& C) { const int st = b / 1024, sb = b % 1024, swz = sb ^ (((sb >> 9) & 1) << 5); R = (st >> 1) * 16 + swz / 64; C = (st & 1) * 32 + (swz % 64) / 2; }
__host__ __device__ __forceinline__ int perm32(int rho) { const int n = rho >> 4, i = rho & 15; return 8 * (i >> 2) + 4 * n + (i & 3); }

struct Unit { int pm, pn, z; };
struct Gemm { const bf16_t* A; const bf16_t* Bt; int M, N, K; size_t zA, zB; };

struct StaticOrder {
    int nM, nN, nwg, G, c, nz;
    __device__ void init(int M, int N, int G_, int c_, int nz_) { nM = M / BM; nN = N / BM; nwg = nM * nN; G = G_; c = c_; nz = nz_; }
    __device__ bool next(int i, Unit& u) const {
        const int ti = i / nz; u.z = i - ti * nz;
        const long L = (long)ti * G + c; if (L >= nwg) return false;
        int wgid = (int)L; { const int q = nwg / NXCD, r = nwg % NXCD, xcd = wgid % NXCD, off = wgid / NXCD; wgid = (xcd < r ? xcd * (q + 1) : r * (q + 1) + (xcd - r) * q) + off; }
        const int nig = WGM * nN, gid = wgid / nig, fm = gid * WGM, gsz = (nM - fm) < WGM ? (nM - fm) : WGM;
        u.pm = fm + ((wgid % nig) % gsz); u.pn = (wgid % nig) / gsz; return true;
    }
};

struct EpiStore {
    bf16_t* O; int ldc;
    __device__ __forceinline__ void operator()(const f32x4 (&acc)[2][2][4][2], const Unit& u, int wr, int wc, int fr, int fq) const {
        const int row0 = u.pm * BM + wr * 64 + fr, col0 = u.pn * BM + wc * 32 + 8 * fq;
#pragma unroll
        for (int ai = 0; ai < 2; ++ai)
#pragma unroll
            for (int m = 0; m < 4; ++m) { bf16_t* rowp = O + (size_t)(row0 + ai * HALF + m * 16) * ldc + col0;
#pragma unroll
                for (int bj = 0; bj < 2; ++bj) { const f32x4 v0 = acc[ai][bj][m][0], v1 = acc[ai][bj][m][1];
                    u32x4 w; w.x = cvt_pk_bf16(v0[0], v0[1]); w.y = cvt_pk_bf16(v0[2], v0[3]); w.z = cvt_pk_bf16(v1[0], v1[1]); w.w = cvt_pk_bf16(v1[2], v1[3]);
                    *(u32x4*)(rowp + bj * HALF) = w; } }
    }
};
struct EpiStoreGate {
    bf16_t* O; int ldc; int tile0; const float* bmerge;
    __device__ __forceinline__ void operator()(const f32x4 (&acc)[2][2][4][2], const Unit& u, int wr, int wc, int fr, int fq) const {
        const int row0 = u.pm * BM + wr * 64 + fr, col0 = u.pn * BM + wc * 32 + 8 * fq;
        const bool gate = u.pn >= tile0;
#pragma unroll
        for (int bj = 0; bj < 2; ++bj) {
            f32x4 b0 = {0.f, 0.f, 0.f, 0.f}, b1 = {0.f, 0.f, 0.f, 0.f};
            if (gate) { const float* bp = bmerge + (u.pn - tile0) * BM + wc * 32 + 8 * fq + bj * HALF; b0 = *(const f32x4*)bp; b1 = *(const f32x4*)(bp + 4); }
#pragma unroll
            for (int ai = 0; ai < 2; ++ai)
#pragma unroll
                for (int m = 0; m < 4; ++m) { bf16_t* rowp = O + (size_t)(row0 + ai * HALF + m * 16) * ldc + col0 + bj * HALF;
                    f32x4 v0 = acc[ai][bj][m][0], v1 = acc[ai][bj][m][1];
                    if (gate) { v0 = v0 + b0; v1 = v1 + b1;
                        v0[0] = sigmoidf_(v0[0]); v0[1] = sigmoidf_(v0[1]); v0[2] = sigmoidf_(v0[2]); v0[3] = sigmoidf_(v0[3]);
                        v1[0] = sigmoidf_(v1[0]); v1[1] = sigmoidf_(v1[1]); v1[2] = sigmoidf_(v1[2]); v1[3] = sigmoidf_(v1[3]); }
                    u32x4 w; w.x = cvt_pk_bf16(v0[0], v0[1]); w.y = cvt_pk_bf16(v0[2], v0[3]); w.z = cvt_pk_bf16(v1[0], v1[1]); w.w = cvt_pk_bf16(v1[2], v1[3]);
                    *(u32x4*)rowp = w; }
        }
    }
};
struct EpiMerge {
    bf16_t* Mo; const bf16_t* P;
    __device__ __forceinline__ void operator()(f32x4 (&acc)[2][2][4][2], const Unit& u, int wr, int wc, int fr, int fq) const {
        const int row0 = u.pm * BM + wr * 64 + fr, col0 = u.pn * BM + wc * 32 + 8 * fq;
        const int z = u.z;
#pragma unroll
        for (int bj = 0; bj < 2; ++bj) {
            const int col = col0 + bj * HALF;
#pragma unroll
            for (int ai = 0; ai < 2; ++ai)
#pragma unroll
                for (int m = 0; m < 4; ++m) {
                    const int row = row0 + ai * HALF + m * 16;
                    const bf16_t* gp = P + (size_t)row * NP + COL_MG + z * DM + col;
                    const u32x4 g = *(const u32x4*)gp;
                    float r[8] = {bflo(g.x), bfhi(g.x), bflo(g.y), bfhi(g.y), bflo(g.z), bfhi(g.z), bflo(g.w), bfhi(g.w)};
#pragma unroll
                    for (int e = 0; e < 8; ++e) r[e] = fmaxf(r[e], 1e-30f);
                    if (z < 2) { const u32x4 h = *(const u32x4*)(gp + DM);
                        const float d[8] = {bflo(h.x), bfhi(h.x), bflo(h.y), bfhi(h.y), bflo(h.z), bfhi(h.z), bflo(h.w), bfhi(h.w)};
#pragma unroll
                        for (int e = 0; e < 8; ++e) r[e] *= __builtin_amdgcn_rcpf(fmaxf(d[e], 1e-30f)); }
                    f32x4& v0 = acc[ai][bj][m][0]; f32x4& v1 = acc[ai][bj][m][1];
                    v0[0] *= r[0]; v0[1] *= r[1]; v0[2] *= r[2]; v0[3] *= r[3]; v1[0] *= r[4]; v1[1] *= r[5]; v1[2] *= r[6]; v1[3] *= r[7];
                    if (z == 2) { u32x4 w; w.x = cvt_pk_bf16(v0[0], v0[1]); w.y = cvt_pk_bf16(v0[2], v0[3]); w.z = cvt_pk_bf16(v1[0], v1[1]); w.w = cvt_pk_bf16(v1[2], v1[3]);
                        *(u32x4*)(Mo + (size_t)row * DM + col) = w; }
                }
        }
    }
};
struct EpiOut {
    bf16_t* O; float* rowss;
    __device__ __forceinline__ void operator()(const f32x4 (&acc)[2][2][4][2], const Unit& u, int wr, int wc, int fr, int fq) const {
        const int row0 = u.pm * BM + wr * 64 + fr, col0 = u.pn * BM + wc * 32 + 8 * fq;
#pragma unroll
        for (int ai = 0; ai < 2; ++ai)
#pragma unroll
            for (int m = 0; m < 4; ++m) { const int row = row0 + ai * HALF + m * 16; bf16_t* rowp = O + (size_t)row * DM + col0; float s = 0.f;
#pragma unroll
                for (int bj = 0; bj < 2; ++bj) { const f32x4 v0 = acc[ai][bj][m][0], v1 = acc[ai][bj][m][1];
                    s += (v0[0] * v0[0] + v0[1] * v0[1]) + (v0[2] * v0[2] + v0[3] * v0[3]) + (v1[0] * v1[0] + v1[1] * v1[1]) + (v1[2] * v1[2] + v1[3] * v1[3]);
                    u32x4 w; w.x = cvt_pk_bf16(v0[0], v0[1]); w.y = cvt_pk_bf16(v0[2], v0[3]); w.z = cvt_pk_bf16(v1[0], v1[1]); w.w = cvt_pk_bf16(v1[2], v1[3]);
                    *(u32x4*)(rowp + bj * HALF) = w; }
                s += __shfl_xor(s, 16); s += __shfl_xor(s, 32);
                if (fq == 0) atomicAdd(rowss + row, s); }
    }
};

template <class Epi, bool KEEP_Z = false>
__device__ __forceinline__ void gemm_phase(LAS unsigned char* lds, const Gemm g, const StaticOrder& S, const Epi& E) {
    const int tid = fresh_tid(), wid = __builtin_amdgcn_readfirstlane(tid >> 6), lane = tid & 63, wr = wid >> 2, wc = wid & 3, fr = lane & 15, fq = lane >> 4;
    const int K = g.K, nt = K / BK;
    unsigned voffA[2], voffB[2];
#pragma unroll
    for (int i = 0; i < 2; ++i) { int R, C; stage_rc(tid * 16 + i * 8192, R, C); const int Rb = (R & ~31) + perm32(R & 31);
        voffA[i] = (unsigned)(R * K + C) * 2u; voffB[i] = (unsigned)(Rb * K + C) * 2u; }
    const size_t kstep = (size_t)(BK * 2);
    const size_t hstep = (size_t)HALF * K * 2;
    const size_t tstep = 2 * hstep;
    const unsigned ldsw = (unsigned)wid * 1024u;
    const int aoff = lds_byte(wr * 64 + fr, fq * 8), boff = lds_byte(wc * 32 + fr, fq * 8);
#define PG8_SA(b, h) (((b) * 2 + (h)) * HTB)
#define PG8_SB(b, h) ((4 + (b) * 2 + (h)) * HTB)
#define PG8_STAGE(bufoff, gbase, voff) do { _Pragma("unroll") for (int _i = 0; _i < 2; ++_i) \
        __builtin_amdgcn_global_load_lds((const unsigned*)((const char*)(gbase) + (voff)[_i]), (LAS unsigned*)(lds + (bufoff) + ldsw + _i * 8192), 16, 0, 0); } while (0)
#define PG8_LDA(dst, b, h) do { _Pragma("unroll") for (int m = 0; m < 4; ++m) _Pragma("unroll") for (int k = 0; k < 2; ++k) dst[m][k] = *(const LAS bf16x8*)(lds + PG8_SA(b, h) + aoff + m * 2048 + k * 1024); } while (0)
#define PG8_LDB(dst, b, h) do { _Pragma("unroll") for (int n = 0; n < 2; ++n) _Pragma("unroll") for (int k = 0; k < 2; ++k) dst[n][k] = *(const LAS bf16x8*)(lds + PG8_SB(b, h) + boff + n * 2048 + k * 1024); } while (0)
#define PG8_MMA(ai, bj, At, Bt) do { __builtin_amdgcn_s_setprio(1); _Pragma("unroll") for (int m = 0; m < 4; ++m) _Pragma("unroll") for (int n = 0; n < 2; ++n) _Pragma("unroll") for (int k = 0; k < 2; ++k) \
        acc[ai][bj][m][n] = __builtin_amdgcn_mfma_f32_16x16x32_bf16(Bt[n][k], At[m][k], acc[ai][bj][m][n], 0, 0, 0); __builtin_amdgcn_s_setprio(0); } while (0)
#define PG8_WAIT_V(n) asm volatile("s_waitcnt vmcnt(" #n ")" ::: "memory")
#define PG8_WAIT_L(n) asm volatile("s_waitcnt lgkmcnt(" #n ")" ::: "memory")
#define PG8_BAR __builtin_amdgcn_s_barrier()
#define PG8_SCHED __builtin_amdgcn_sched_barrier(0)
    Unit cur, nxt; int ui = 0;
    if (!S.next(0, cur)) return;
    f32x4 acc[2][2][4][2];
#pragma unroll
    for (int a = 0; a < 2; ++a)
#pragma unroll
        for (int b = 0; b < 2; ++b)
#pragma unroll
            for (int m = 0; m < 4; ++m)
#pragma unroll
                for (int n = 0; n < 2; ++n) acc[a][b][m][n] = (f32x4){0.f, 0.f, 0.f, 0.f};
    bf16x8 At[4][2], B0[2][2], B1[2][2];
    const char* cA = (const char*)g.A + (size_t)cur.pm * tstep + (size_t)cur.z * g.zA; const char* cB = (const char*)g.Bt + (size_t)cur.pn * tstep + (size_t)cur.z * g.zB;
    {
        PG8_STAGE(PG8_SB(0, 0), cB, voffB); PG8_STAGE(PG8_SB(0, 1), cB + hstep, voffB); PG8_STAGE(PG8_SA(0, 0), cA, voffA); PG8_STAGE(PG8_SA(0, 1), cA + hstep, voffA);
        if (wr == 1) PG8_BAR;
        PG8_WAIT_V(2); PG8_BAR;
        PG8_STAGE(PG8_SB(1, 0), cB + kstep, voffB); PG8_STAGE(PG8_SA(1, 0), cA + kstep, voffA); PG8_STAGE(PG8_SB(1, 1), cB + hstep + kstep, voffB);
        PG8_WAIT_V(6); PG8_BAR;
    }
    for (;;) {
        const bool has_next = S.next(ui + 1, nxt);
        const char* nA = has_next ? (const char*)g.A + (size_t)nxt.pm * tstep + (size_t)nxt.z * g.zA : cA; const char* nB = has_next ? (const char*)g.Bt + (size_t)nxt.pn * tstep + (size_t)nxt.z * g.zB : cB;
        for (int t = 0; t < nt; t += 2) {
            const bool last = (t == nt - 2);
            const char* a1 = cA + (size_t)(t + 1) * kstep;
            const char* a2 = last ? nA : cA + (size_t)(t + 2) * kstep; const char* b2 = last ? nB : cB + (size_t)(t + 2) * kstep;
            const char* a3 = a2 + kstep; const char* b3 = b2 + kstep;
            PG8_LDB(B0, 0, 0); PG8_LDB(B1, 0, 1); PG8_SCHED; PG8_LDA(At, 0, 0); PG8_STAGE(PG8_SA(1, 1), a1 + hstep, voffA);
            PG8_WAIT_V(8); PG8_WAIT_L(0); PG8_BAR; PG8_MMA(0, 0, At, B0); PG8_MMA(0, 1, At, B1); PG8_BAR; PG8_SCHED;
            PG8_LDA(At, 0, 1); PG8_STAGE(PG8_SB(0, 0), b2, voffB); PG8_STAGE(PG8_SB(0, 1), b2 + hstep, voffB); PG8_STAGE(PG8_SA(0, 0), a2, voffA);
            PG8_WAIT_V(8); PG8_WAIT_L(0); PG8_BAR; PG8_MMA(1, 0, At, B0); PG8_MMA(1, 1, At, B1); PG8_BAR; PG8_SCHED;
            PG8_LDB(B0, 1, 0); PG8_LDB(B1, 1, 1); PG8_SCHED; PG8_LDA(At, 1, 0); PG8_STAGE(PG8_SA(0, 1), a2 + hstep, voffA);
            PG8_WAIT_V(8); PG8_WAIT_L(0); PG8_BAR; PG8_MMA(0, 0, At, B0); PG8_MMA(0, 1, At, B1); PG8_BAR; PG8_SCHED;
            PG8_LDA(At, 1, 1); PG8_STAGE(PG8_SB(1, 0), b3, voffB); PG8_STAGE(PG8_SB(1, 1), b3 + hstep, voffB); PG8_STAGE(PG8_SA(1, 0), a3, voffA);
            PG8_WAIT_V(8); PG8_WAIT_L(0); PG8_BAR; PG8_MMA(1, 0, At, B0); PG8_MMA(1, 1, At, B1); PG8_BAR; PG8_SCHED;
        }
        if (wr == 0) PG8_BAR;
        E(acc, cur, wr, wc, fr, fq);
        if (!has_next) break;
        if (!KEEP_Z || nxt.z == 0) {
#pragma unroll
        for (int a = 0; a < 2; ++a)
#pragma unroll
            for (int b = 0; b < 2; ++b)
#pragma unroll
                for (int m = 0; m < 4; ++m)
#pragma unroll
                    for (int n = 0; n < 2; ++n) acc[a][b][m][n] = (f32x4){0.f, 0.f, 0.f, 0.f};
        }
        cur = nxt; cA = nA; cB = nB; ++ui;
        if (wr == 1) PG8_BAR;
    }
    PG8_WAIT_V(0);
    PG8_BAR;
#undef PG8_SA
#undef PG8_SB
#undef PG8_STAGE
#undef PG8_LDA
#undef PG8_LDB
#undef PG8_MMA
#undef PG8_WAIT_V
#undef PG8_WAIT_L
#undef PG8_BAR
#undef PG8_SCHED
}
}

struct Params {
    const float* in[23];
    float* out;
    unsigned char* ws;
};

__device__ __forceinline__ int map_in(int d) {
    if (d < 3200) return 6152 + d; if (d < 3208) return 5120 + (d - 3200); if (d < 3328) return -1; if (d < 4352) return 9352 + (d - 3328);
    if (d < 9472) return d - 4352; if (d < 10496) return 5128 + (d - 9472); return 10376 + (d - 10496); }
template <bool MAP>
__device__ __forceinline__ void transpose_item(const float* W, int K, int Nsrc, bf16_t* WT, LAS float* scr, int item, int nblk, int lane) {
    const int kb = item / nblk, nb = item - kb * nblk, k0 = 64 * kb, n0 = 32 * nb;
    if (MAP && n0 == COL_FL) {
        const int d = n0 + (lane & 31); const int sc = map_in(d);
#pragma unroll 8
        for (int i = 0; i < 32; ++i) { const int kk = 2 * i + (lane >> 5); scr[kk * 33 + (lane & 31)] = (sc >= 0) ? W[(size_t)(k0 + kk) * Nsrc + sc] : 0.f; }
    } else {
        const int sc0 = MAP ? map_in(n0) : n0;
        const int r8 = lane >> 3, c4 = lane & 7;
        f32x4 v[8];
#pragma unroll
        for (int i = 0; i < 8; ++i) v[i] = (sc0 >= 0) ? *(const f32x4*)(W + (size_t)(k0 + 8 * i + r8) * Nsrc + sc0 + 4 * c4) : (f32x4){0.f, 0.f, 0.f, 0.f};
#pragma unroll
        for (int i = 0; i < 8; ++i) { LAS float* d = scr + (8 * i + r8) * 33 + 4 * c4; d[0] = v[i][0]; d[1] = v[i][1]; d[2] = v[i][2]; d[3] = v[i][3]; }
    }
    LDS_WAIT(); asm volatile("" ::: "memory");
    const int c = lane & 7;
#pragma unroll
    for (int j = 0; j < 4; ++j) { const int n = (lane >> 3) + 8 * j; const LAS float* s = scr + (8 * c) * 33 + n;
        u32x4 o; o.x = pk2(s[0 * 33], s[1 * 33]); o.y = pk2(s[2 * 33], s[3 * 33]); o.z = pk2(s[4 * 33], s[5 * 33]); o.w = pk2(s[6 * 33], s[7 * 33]);
        *(u32x4*)(WT + (size_t)(n0 + n) * K + k0 + 8 * c) = o; }
    LDS_WAIT(); asm volatile("" ::: "memory");
}
__device__ __forceinline__ void convert_win(const float* w_in_l, bf16_t* WIN, LAS float* scr, int gw, int NGW, int lane) {
    constexpr int NBLK = NP / 32, NITEMS = (DM / 64) * NBLK;
    for (int it = gw; it < NITEMS; it += NGW) transpose_item<true>(w_in_l, DM, NIN, WIN, scr, it, NBLK, lane);
}
__device__ __forceinline__ void rms_row_store(const f32x4 (&v)[8], float ssum, const float* g, bf16_t* orow, int lane) {
    const float rs = 1.0f / sqrtf(ssum * (1.0f / DM) + NORM_EPS);
#pragma unroll
    for (int j = 0; j < 8; ++j) { const f32x4 gv = *((const f32x4*)g + lane + 64 * j);
        u32x2 w; w.x = pk2(v[j][0] * rs * gv[0], v[j][1] * rs * gv[1]); w.y = pk2(v[j][2] * rs * gv[2], v[j][3] * rs * gv[3]);
        *((u32x2*)orow + lane + 64 * j) = w; }
}

__device__ __forceinline__ void vt_unit(LAS unsigned char* lds, const bf16_t* P, bf16_t* Vt, const float* bfp, float* LSP, float* TS, unsigned* KN, int unit, int tid) {
    const int h = unit & 7, t0 = (unit >> 3) * 64;
    {
        const u32x4* kp = (const u32x4*)(P + (size_t)(t0 + (tid >> 3)) * NP + COL_K + h * 128 + (tid & 7) * 16);
        const u32x4 a = kp[0], b = kp[1]; float ss = 0.f;
        ss += bflo(a.x) * bflo(a.x) + bfhi(a.x) * bfhi(a.x) + bflo(a.y) * bflo(a.y) + bfhi(a.y) * bfhi(a.y) + bflo(a.z) * bflo(a.z) + bfhi(a.z) * bfhi(a.z) + bflo(a.w) * bflo(a.w) + bfhi(a.w) * bfhi(a.w);
        ss += bflo(b.x) * bflo(b.x) + bfhi(b.x) * bfhi(b.x) + bflo(b.y) * bflo(b.y) + bfhi(b.y) * bfhi(b.y) + bflo(b.z) * bflo(b.z) + bfhi(b.z) * bfhi(b.z) + bflo(b.w) * bflo(b.w) + bfhi(b.w) * bfhi(b.w);
        ss += dppf<0xB1>(ss); ss += dppf<0x4E>(ss); ss += dppf<0x141>(ss);
        ss = fmaxf(ss, __shfl_xor(ss, 8)); ss = fmaxf(ss, __shfl_xor(ss, 16)); ss = fmaxf(ss, __shfl_xor(ss, 32));
        if ((tid & 63) == 0) atomicMax(KN + h, __float_as_uint(ss));
    }
    if (tid < 64) {
        float x = logsigf_(bf2f(P[(size_t)(t0 + tid) * NP + COL_FL + h]) + bfp[h]);
#pragma unroll
        for (int o = 1; o < 64; o <<= 1) { const float y = __shfl_up(x, o); if (tid >= o) x += y; }
        LSP[(size_t)h * S_ + t0 + tid] = x; if (tid == 63) TS[h * 256 + (unit >> 3)] = x;
    }
    LAS unsigned short* T = (LAS unsigned short*)lds;
#pragma unroll
    for (int i = 0; i < 2; ++i) { const int id = tid + 512 * i, row = id >> 4, c16 = id & 15;
        const u32x4 v = *(const u32x4*)(P + (size_t)(t0 + row) * NP + COL_V + h * 128 + c16 * 8);
        LAS unsigned* dst = (LAS unsigned*)(T + row * 130 + c16 * 8); dst[0] = v.x; dst[1] = v.y; dst[2] = v.z; dst[3] = v.w; }
    __syncthreads();
#pragma unroll
    for (int i = 0; i < 2; ++i) { const int id = tid + 512 * i, d = id >> 3, t8 = id & 7;
        const LAS unsigned short* s = T + (t8 * 8) * 130 + d;
        u32x4 o; o.x = (unsigned)s[0] | ((unsigned)s[130] << 16); o.y = (unsigned)s[2 * 130] | ((unsigned)s[3 * 130] << 16);
        o.z = (unsigned)s[4 * 130] | ((unsigned)s[5 * 130] << 16); o.w = (unsigned)s[6 * 130] | ((unsigned)s[7 * 130] << 16);
        *(u32x4*)(Vt + (size_t)(h * 128 + d) * S_ + t0 + t8 * 8) = o; }
    __syncthreads();
}
struct RwkvW { const float *mu, *w0, *a0, *k_k, *k_a, *r_k; const bf16_t *wupt, *aupt; };
__device__ __forceinline__ void rwkv_prep_unit(LAS unsigned char* lds, const bf16_t* P, const RwkvW& W, float* decay, bf16_t* okk, bf16_t* ob, bf16_t* ok, bf16_t* orr, bf16_t* ov, float* bonus, int unit, int tid) {
    LAS unsigned short* X = (LAS unsigned short*)lds;
    LAS unsigned short* tw = X + 17 * 3200;
    LAS unsigned short* ca = tw + 16 * 72;
    const int t0 = unit * 16, wave = tid >> 6, lane = tid & 63, fr = lane & 15, fq = lane >> 4;
    {
        u32x4 v[14];
#pragma unroll
        for (int i = 0; i < 14; ++i) { const int id = tid + 512 * i; const int row = id / 400, ch = id - row * 400; const int t = t0 - 1 + row;
            v[i] = (u32x4){0u, 0u, 0u, 0u};
            if (id < 6800 && t >= 0) v[i] = *(const u32x4*)(P + (size_t)t * NP + COL_PC + ch * 8); }
#pragma unroll
        for (int i = 0; i < 14; ++i) { const int id = tid + 512 * i; const int row = id / 400, ch = id - row * 400;
            if (id < 6800) *(LAS u32x4*)(X + row * 3200 + ch * 8) = v[i]; }
    }
    __syncthreads();
#pragma unroll
    for (int i = 0; i < 4; ++i) { const int e = tid + 512 * i, tt = e >> 7, j = e & 127, col = 3072 + j;
        const float cur = bf2f(X[(tt + 1) * 3200 + col]), prev = bf2f(X[tt * 3200 + col]);
        const float xs = cur + (prev - cur) * W.mu[col];
        if (j < 64) tw[tt * 72 + j] = (unsigned short)f2bf(tanhf(xs)); else ca[tt * 72 + j - 64] = (unsigned short)f2bf(xs); }
    __syncthreads();
    bf16x8 Aw[2], Aa[2];
#pragma unroll
    for (int kk = 0; kk < 2; ++kk) { Aw[kk] = *(const LAS bf16x8*)(tw + fr * 72 + kk * 32 + fq * 8); Aa[kk] = *(const LAS bf16x8*)(ca + fr * 72 + kk * 32 + fq * 8); }
#pragma unroll 1
    for (int hi = 0; hi < 2; ++hi) {
        const int hh = wave + 8 * hi;
        float kkv[4][4], av[4][4], bop[4];
#pragma unroll
        for (int jj = 0; jj < 4; ++jj) bop[jj] = 0.f;
#pragma unroll
        for (int n = 0; n < 4; ++n) {
            const int c = hh * 64 + 16 * n + fr;
            f32x4 accw = {0.f, 0.f, 0.f, 0.f}, acca = {0.f, 0.f, 0.f, 0.f};
#pragma unroll
            for (int kk = 0; kk < 2; ++kk) { const bf16x8 Bw = *(const bf16x8*)(W.wupt + (size_t)c * 64 + kk * 32 + fq * 8), Ba = *(const bf16x8*)(W.aupt + (size_t)c * 64 + kk * 32 + fq * 8);
                accw = __builtin_amdgcn_mfma_f32_16x16x32_bf16(Aw[kk], Bw, accw, 0, 0, 0); acca = __builtin_amdgcn_mfma_f32_16x16x32_bf16(Aa[kk], Ba, acca, 0, 0, 0); }
            const float w0c = W.w0[c], a0c = W.a0[c], kkc = W.k_k[c], kac = W.k_a[c], rkc = W.r_k[c];
            const float mur = W.mu[c], muk = W.mu[1024 + c], muv = W.mu[2048 + c];
#pragma unroll
            for (int jj = 0; jj < 4; ++jj) {
                const int tt = 4 * fq + jj;
                const LAS unsigned short* x1 = X + (tt + 1) * 3200 + c; const LAS unsigned short* x0 = X + tt * 3200 + c;
                const float r1 = bf2f(x1[0]), k1 = bf2f(x1[1024]), v1 = bf2f(x1[2048]);
                const float cr = r1 + (bf2f(x0[0]) - r1) * mur, ck = k1 + (bf2f(x0[1024]) - k1) * muk, cv = v1 + (bf2f(x0[2048]) - v1) * muv;
                const float sig = 1.0f / (1.0f + __expf(-(w0c + accw[jj])));
                const float dec = __expf(-0.6065306597126334f * sig);
                const float a = 1.0f / (1.0f + __expf(-(a0c + acca[jj])));
                const float kp = ck * (1.0f + (a - 1.0f) * kac);
                kkv[n][jj] = ck * kkc; av[n][jj] = a; bop[jj] += cr * kp * rkc;
                const size_t o = (size_t)(t0 + tt) * DBR + c;
                decay[o] = dec; ok[o] = (bf16_t)f2bf(kp); orr[o] = (bf16_t)f2bf(cr); ov[o] = (bf16_t)f2bf(cv);
            }
        }
#pragma unroll
        for (int jj = 0; jj < 4; ++jj) {
            float ss = (kkv[0][jj] * kkv[0][jj] + kkv[1][jj] * kkv[1][jj]) + (kkv[2][jj] * kkv[2][jj] + kkv[3][jj] * kkv[3][jj]);
            ss = rowsum16(ss);
            const float rs = 1.0f / sqrtf(fmaxf(ss, 1e-24f));
            const float bo = rowsum16(bop[jj]);
            const int t = t0 + 4 * fq + jj;
#pragma unroll
            for (int n = 0; n < 4; ++n) { const size_t o = (size_t)t * DBR + hh * 64 + 16 * n + fr; const float kkn = kkv[n][jj] * rs;
                okk[o] = (bf16_t)f2bf(kkn); ob[o] = (bf16_t)f2bf(kkn * av[n][jj]); }
            if (fr == 0) bonus[(size_t)t * 16 + hh] = bo;
        }
    }
    __syncthreads();
}

struct RwStep { f32x4 w, kk, bb, kv, rr; };
__device__ __forceinline__ void rwkv_seq(LAS unsigned char* lds, const float* decay, const bf16_t* akk, const bf16_t* ab, const bf16_t* ak, const bf16_t* ar, const bf16_t* av, float* Yraw, int blk, int tid) {
    const int hh = blk >> 2, qv = blk & 3;
    const int wave = tid >> 6, lane = tid & 63;
    LAS float* tile = (LAS float*)lds;
    LAS float* vbuf = (LAS float*)(lds + 81920);
    LAS float* ypart = (LAS float*)(lds + 81920 + 4096);
    const bool loader = wave >= 4;
    const int lt = tid & 255;
    constexpr int NT = S_ / 32;
    f32x4 rw[2]; u32x2 rk[4][2]; unsigned rv[2];
    const size_t cbase = (size_t)hh * 64;
#define RW_ISSUE(n) do { _Pragma("unroll") for (int i_ = 0; i_ < 2; ++i_) { const int e_ = lt + 256 * i_, st_ = e_ >> 4, c4_ = e_ & 15; \
        const size_t gi_ = (size_t)((n) * 32 + st_) * DBR + cbase + c4_ * 4; \
        rw[i_] = *(const f32x4*)(decay + gi_); rk[0][i_] = *(const u32x2*)(akk + gi_); rk[1][i_] = *(const u32x2*)(ab + gi_); rk[2][i_] = *(const u32x2*)(ak + gi_); rk[3][i_] = *(const u32x2*)(ar + gi_); \
        rv[i_] = av[(size_t)((n) * 32 + st_) * DBR + cbase + qv * 16 + c4_]; } } while (0)
#define RW_WRITE(b) do { _Pragma("unroll") for (int i_ = 0; i_ < 2; ++i_) { const int e_ = lt + 256 * i_, st_ = e_ >> 4, c4_ = e_ & 15; \
        LAS float* d_ = tile + ((b) * 32 + st_) * 320 + c4_ * 4; *(LAS f32x4*)d_ = rw[i_]; \
        _Pragma("unroll") for (int a_ = 0; a_ < 4; ++a_) { f32x4 f_; f_[0] = bflo(rk[a_][i_].x); f_[1] = bfhi(rk[a_][i_].x); f_[2] = bflo(rk[a_][i_].y); f_[3] = bfhi(rk[a_][i_].y); *(LAS f32x4*)(d_ + 64 * (a_ + 1)) = f_; } \
        vbuf[((b) * 16 + c4_) * 32 + st_] = bf2f(rv[i_]); } } while (0)
#define RW_FLUSH(n, b) do { _Pragma("unroll") for (int i_ = 0; i_ < 2; ++i_) { const int e_ = lt + 256 * i_, st_ = e_ >> 4, r_ = e_ & 15; \
        const LAS f32x4* yp_ = (const LAS f32x4*)(ypart + (((b) * 32 + st_) * 16 + r_) * 8); const f32x4 a_ = yp_[0], c_ = yp_[1]; \
        Yraw[(size_t)((n) * 32 + st_) * DBR + cbase + qv * 16 + r_] = ((a_[0] + a_[1]) + (a_[2] + a_[3])) + ((c_[0] + c_[1]) + (c_[2] + c_[3])); } } while (0)
    if (loader) { RW_ISSUE(0); RW_WRITE(0); }
    __syncthreads();
    const int row_l = (wave & 3) * 4 + (lane >> 4), ks = lane & 15;
    f32x2 s01 = {0.f, 0.f}, s23 = {0.f, 0.f};
#define RW_LD(dst, st_) do { const LAS float* bs_ = tb + (st_) * 320; dst.w = *(const LAS f32x4*)bs_; dst.kk = *(const LAS f32x4*)(bs_ + 64); dst.bb = *(const LAS f32x4*)(bs_ + 128); \
        dst.kv = *(const LAS f32x4*)(bs_ + 192); dst.rr = *(const LAS f32x4*)(bs_ + 256); } while (0)
#define RW_STEP(src, st_) do { const f32x2 t_ = s01 * (f32x2){src.kk[0], src.kk[1]} + s23 * (f32x2){src.kk[2], src.kk[3]}; \
        const float sa_ = -rowsum16(t_[0] + t_[1]); const float vr_ = vq[(st_) >> 2][(st_) & 3]; \
        s01 = s01 * (f32x2){src.w[0], src.w[1]} + sa_ * (f32x2){src.bb[0], src.bb[1]} + vr_ * (f32x2){src.kv[0], src.kv[1]}; \
        s23 = s23 * (f32x2){src.w[2], src.w[3]} + sa_ * (f32x2){src.bb[2], src.bb[3]} + vr_ * (f32x2){src.kv[2], src.kv[3]}; \
        const f32x2 yv_ = s01 * (f32x2){src.rr[0], src.rr[1]} + s23 * (f32x2){src.rr[2], src.rr[3]}; \
        float y_ = yv_[0] + yv_[1]; y_ += dppf<0xB1>(y_); \
        yb[(st_) * 128] = y_; } while (0)
    for (int n = 0; n < NT; ++n) {
        const int b = n & 1;
        if (loader) {
            if (n + 1 < NT) RW_ISSUE(n + 1);
            if (n > 0) RW_FLUSH(n - 1, b ^ 1);
            if (n + 1 < NT) RW_WRITE(b ^ 1);
        } else {
            RwStep ca, cb;
            const LAS float* tb = tile + b * (32 * 320) + 4 * ks;
            LAS float* yb = ypart + (b * 512 + row_l) * 8 + (ks >> 1);
            f32x4 vq[8];
            RW_LD(ca, 0);
            __builtin_amdgcn_sched_barrier(0);
            { const LAS f32x4* vb = (const LAS f32x4*)(vbuf + (b * 16 + row_l) * 32);
#pragma unroll
              for (int q = 0; q < 8; ++q) vq[q] = vb[q]; }
            __builtin_amdgcn_sched_barrier(0);
#pragma unroll
            for (int st = 0; st < 32; st += 2) {
                RW_LD(cb, st + 1);
                RW_STEP(ca, st);
                if (st + 2 < 32) RW_LD(ca, st + 2);
                RW_STEP(cb, st + 1);
            }
        }
        __syncthreads();
    }
    if (loader) RW_FLUSH(NT - 1, (NT - 1) & 1);
    __syncthreads();
#undef RW_ISSUE
#undef RW_WRITE
#undef RW_FLUSH
#undef RW_LD
#undef RW_STEP
}

struct LruW { const float *conv_w, *conv_b, *gate_b, *lam; const bf16_t* wgt; };
__device__ __forceinline__ void lru_chunk_unit(LAS unsigned char* lds, const bf16_t* P, const LruW& W, bf16_t* HL, bf16_t* ACUM, float* AGA, float* AGB, int unit, int tid) {
    const int h = unit & 15, ci = unit >> 4, t0 = ci * 64;
    const int wave = tid >> 6, lane = tid & 63;
    LAS float* xcf = (LAS float*)lds;
    LAS float* As = xcf + 4096;
    LAS float* Bs = As + 4096;
    LAS float* SA = Bs + 4096;
    LAS float* SB = SA + 512;
    LAS unsigned short* xcb = (LAS unsigned short*)(SB + 512 + 64);
    const int c = tid & 63, tg = tid >> 6;
    const int ch = h * 64 + c;
    const float cw0 = W.conv_w[0 * DBR + ch], cw1 = W.conv_w[1 * DBR + ch], cw2 = W.conv_w[2 * DBR + ch], cw3 = W.conv_w[3 * DBR + ch], cb = W.conv_b[ch];
    float xa[11];
#pragma unroll
    for (int i = 0; i < 11; ++i) { const int t = t0 + tg * 8 + i - 3; xa[i] = (t >= 0) ? bf2f(P[(size_t)t * NP + COL_XA + ch]) : 0.f; }
    const int tb = wave & 3, chh = wave >> 2, fr = lane & 15, fq = lane >> 4;
    bf16x8 Bf[2][2][2];
    float gb0[2], gb1[2], sp[2];
#pragma unroll
    for (int n = 0; n < 2; ++n) { const int j = 32 * chh + 16 * n + fr;
        gb0[n] = W.gate_b[h * 64 + j]; gb1[n] = W.gate_b[DBR + h * 64 + j]; sp[n] = softplusf_(-W.lam[h * 64 + j]);
#pragma unroll
        for (int g = 0; g < 2; ++g)
#pragma unroll
            for (int kk = 0; kk < 2; ++kk) Bf[g][n][kk] = *(const bf16x8*)(W.wgt + ((size_t)((g * 16 + h) * 64 + j)) * 64 + kk * 32 + fq * 8); }
#pragma unroll
    for (int tt = 0; tt < 8; ++tt) {
        const float xc = cb + cw0 * xa[tt] + cw1 * xa[tt + 1] + cw2 * xa[tt + 2] + cw3 * xa[tt + 3];
        xcf[(tg * 8 + tt) * 64 + c] = xc; xcb[(tg * 8 + tt) * 72 + c] = (unsigned short)f2bf(xc);
    }
    __syncthreads();
    {
        bf16x8 Af[2];
#pragma unroll
        for (int kk = 0; kk < 2; ++kk) Af[kk] = *(const LAS bf16x8*)(xcb + (tb * 16 + fr) * 72 + kk * 32 + fq * 8);
        f32x4 acc[2][2];
#pragma unroll
        for (int g = 0; g < 2; ++g)
#pragma unroll
            for (int n = 0; n < 2; ++n) { acc[g][n] = (f32x4){0.f, 0.f, 0.f, 0.f};
#pragma unroll
                for (int kk = 0; kk < 2; ++kk) acc[g][n] = __builtin_amdgcn_mfma_f32_16x16x32_bf16(Af[kk], Bf[g][n][kk], acc[g][n], 0, 0, 0); }
#pragma unroll
        for (int n = 0; n < 2; ++n)
#pragma unroll
            for (int jj = 0; jj < 4; ++jj) {
                const int tl = tb * 16 + 4 * fq + jj, cc = 32 * chh + 16 * n + fr;
                const float r = 1.0f / (1.0f + __expf(-(acc[0][n][jj] + gb0[n])));
                const float ig = 1.0f / (1.0f + __expf(-(acc[1][n][jj] + gb1[n])));
                const float la = -8.0f * r * sp[n];
                const float a = expf(la);
                float mult = sqrtf(-expm1f(2.0f * la));
                if (t0 + tl == 0) mult = 1.0f;
                As[tl * 64 + cc] = a; Bs[tl * 64 + cc] = mult * ig * xcf[tl * 64 + cc];
            }
    }
    __syncthreads();
    float hl[8], ac[8];
    {
        float hrun = 0.f, arun = 1.f;
#pragma unroll
        for (int tt = 0; tt < 8; ++tt) { const float a = As[(tg * 8 + tt) * 64 + c], b = Bs[(tg * 8 + tt) * 64 + c]; hrun = a * hrun + b; arun *= a; hl[tt] = hrun; ac[tt] = arun; }
        SA[tg * 64 + c] = arun; SB[tg * 64 + c] = hrun;
    }
    __syncthreads();
    float hin = 0.f, cin = 1.f;
    for (int s = 0; s < tg; ++s) { const float sa = SA[s * 64 + c]; hin = sa * hin + SB[s * 64 + c]; cin *= sa; }
#pragma unroll
    for (int tt = 0; tt < 8; ++tt) { const float hv = hl[tt] + ac[tt] * hin, av = ac[tt] * cin; const size_t o = (size_t)(t0 + tg * 8 + tt) * DBR + ch;
        HL[o] = (bf16_t)f2bf(hv); ACUM[o] = (bf16_t)f2bf(av);
        if (tt == 7 && tg == 7) { AGA[(size_t)ci * DBR + ch] = av; AGB[(size_t)ci * DBR + ch] = hv; } }
    __syncthreads();
}

constexpr int AT_KROW = 136 * 2;
constexpr int AT_VROW = 68 * 2;
constexpr int AT_KBYTES = 64 * AT_KROW;
constexpr int AT_VBYTES = 128 * AT_VROW;
constexpr int AT_BUF = AT_KBYTES + AT_VBYTES + 256;
__device__ __forceinline__ void attn_unit(LAS unsigned char* lds, const bf16_t* P, const bf16_t* Vt, const float* C, const float* TS, const unsigned* KN, bf16_t* Yb, int h, int qb, int tid) {
    const int wave = tid >> 6, lane = tid & 63, ql = lane & 31, hf = lane >> 5;
    LAS float* offs = (LAS float*)(lds + 2 * AT_BUF);
    LAS float* needw = offs + 256;
    if (tid < 64) { const f32x4 v = *(const f32x4*)(TS + h * 256 + 4 * tid); float x = (v[0] + v[1]) + (v[2] + v[3]);
#pragma unroll
        for (int o = 1; o < 64; o <<= 1) { const float y = __shfl_up(x, o); if (tid >= o) x += y; }
        const float e0 = x - ((v[0] + v[1]) + (v[2] + v[3]));
        *(LAS f32x4*)(offs + 4 * tid) = (f32x4){e0, e0 + v[0], e0 + v[0] + v[1], e0 + v[0] + v[1] + v[2]}; }
    __syncthreads();
    const int qw0 = qb * 256 + wave * 32, q = qw0 + ql;
    bf16x8 Qf[8];
    { const bf16_t* qp = P + (size_t)q * NP + COL_Q + h * 128 + 8 * hf;
#pragma unroll
      for (int ks = 0; ks < 8; ++ks) Qf[ks] = *(const bf16x8*)(qp + 16 * ks); }
    const float cq = (offs[q >> 6] + C[(size_t)h * S_ + q]) * LOG2E;
    const float SC = 0.08838834764831845f * LOG2E;
    float qss = 0.f;
#pragma unroll
    for (int ks = 0; ks < 8; ++ks)
#pragma unroll
        for (int e = 0; e < 8; ++e) { const float v = bf2f((unsigned)(unsigned short)Qf[ks][e]); qss += v * v; }
    qss += __shfl_xor(qss, 32);
    const float needc = sqrtf(qss) * sqrtf(__uint_as_float(KN[h])) * SC * 1.001f + cq + 40.0f;
    f32x16 O[4];
#pragma unroll
    for (int db = 0; db < 4; ++db)
#pragma unroll
        for (int i = 0; i < 16; ++i) O[db][i] = 0.f;
    float m = -INFINITY, l = 0.f;
    const int ntile = 4 * qb + 4;
    u32x4 kreg[2], vreg[2]; float ckreg = 0.f;
    const bf16_t* kbase = P + COL_K + h * 128;
    const bf16_t* vbase = Vt + (size_t)h * 128 * S_;
    const float* cbase = C + (size_t)h * S_;
#define AT_LOAD(kt_) do { const int k0_ = (kt_) * 64; _Pragma("unroll") for (int i_ = 0; i_ < 2; ++i_) { const int id_ = tid + 512 * i_; \
        kreg[i_] = *(const u32x4*)(kbase + (size_t)(k0_ + (id_ >> 4)) * NP + (id_ & 15) * 8); \
        vreg[i_] = *(const u32x4*)(vbase + (size_t)(id_ >> 3) * S_ + k0_ + (id_ & 7) * 8); } \
        if (tid < 64) ckreg = (offs[(kt_)] + cbase[k0_ + tid]) * LOG2E; } while (0)
#define AT_WRITE(b_) do { LAS unsigned char* bb_ = lds + (b_) * AT_BUF; _Pragma("unroll") for (int i_ = 0; i_ < 2; ++i_) { const int id_ = tid + 512 * i_; \
        *(LAS u32x4*)(bb_ + (id_ >> 4) * AT_KROW + (id_ & 15) * 16) = kreg[i_]; \
        LAS u32x2* vd_ = (LAS u32x2*)(bb_ + AT_KBYTES + (id_ >> 3) * AT_VROW + (id_ & 7) * 16); vd_[0] = (u32x2){vreg[i_].x, vreg[i_].y}; vd_[1] = (u32x2){vreg[i_].z, vreg[i_].w}; } \
        if (tid < 64) *(LAS float*)(bb_ + AT_KBYTES + AT_VBYTES + tid * 4) = ckreg; } while (0)
    AT_LOAD(ntile - 1); AT_WRITE(0);
    if (tid < 16) needw[tid] = INFINITY;
    __syncthreads();
    for (int it = 0; it < ntile; ++it) {
        const int kt = ntile - 1 - it, b = it & 1;
        bool more = (kt > 0);
        if (more) {
            const LAS float* nw = needw + ((it & 1) ^ 1) * 8;
            const f32x4 n0 = *(const LAS f32x4*)nw, n1 = *(const LAS f32x4*)(nw + 4);
            const float need = fmaxf(fmaxf(fmaxf(n0[0], n0[1]), fmaxf(n0[2], n0[3])), fmaxf(fmaxf(n1[0], n1[1]), fmaxf(n1[2], n1[3])));
            more = !(need <= offs[kt] * LOG2E);
        }
        if (more) AT_LOAD(kt - 1);
        const int k0 = kt * 64;
        float nd = INFINITY;
        if (k0 <= qw0 + 31) {
            const LAS unsigned char* Kl = lds + b * AT_BUF;
            const LAS unsigned char* Vl = Kl + AT_KBYTES;
            const LAS float* ckl = (const LAS float*)(Vl + AT_VBYTES);
            f32x16 Sx[2];
#pragma unroll
            for (int kb = 0; kb < 2; ++kb) {
#pragma unroll
                for (int i = 0; i < 16; ++i) Sx[kb][i] = 0.f;
#pragma unroll
                for (int ks = 0; ks < 8; ++ks) { const bf16x8 A = *(const LAS bf16x8*)(Kl + (kb * 32 + ql) * AT_KROW + (16 * ks + 8 * hf) * 2);
                    Sx[kb] = __builtin_amdgcn_mfma_f32_32x32x16_bf16(A, Qf[ks], Sx[kb], 0, 0, 0); }
            }
            const bool diag = (k0 + 63 > qw0);
            float mx = m;
#pragma unroll
            for (int kb = 0; kb < 2; ++kb)
#pragma unroll
                for (int i4 = 0; i4 < 4; ++i4) { const f32x4 ckv = *(const LAS f32x4*)(ckl + 32 * kb + 8 * i4 + 4 * hf);
#pragma unroll
                    for (int j = 0; j < 4; ++j) { const int i = 4 * i4 + j; float s = Sx[kb][i] * SC + (cq - ckv[j]);
                        if (diag) { const int key = k0 + 32 * kb + 8 * i4 + 4 * hf + j; if (key > q) s = -INFINITY; }
                        Sx[kb][i] = s; mx = fmaxf(mx, s); } }
            mx = fmaxf(mx, __shfl_xor(mx, 32));
            const float alpha = __builtin_amdgcn_exp2f(m - mx);
            m = mx; l *= alpha;
#pragma unroll
            for (int kb = 0; kb < 2; ++kb)
#pragma unroll
                for (int i = 0; i < 16; ++i) { const float p = __builtin_amdgcn_exp2f(Sx[kb][i] - mx); Sx[kb][i] = p; l += p; }
#pragma unroll
            for (int db = 0; db < 4; ++db)
#pragma unroll
                for (int i = 0; i < 16; ++i) O[db][i] *= alpha;
            bf16x8 Pf[4];
#pragma unroll
            for (int s = 0; s < 4; ++s) { const int kb = s >> 1, i0 = 8 * (s & 1);
                u32x4 w; w.x = cvt_pk_bf16(Sx[kb][i0 + 0], Sx[kb][i0 + 1]); w.y = cvt_pk_bf16(Sx[kb][i0 + 2], Sx[kb][i0 + 3]); w.z = cvt_pk_bf16(Sx[kb][i0 + 4], Sx[kb][i0 + 5]); w.w = cvt_pk_bf16(Sx[kb][i0 + 6], Sx[kb][i0 + 7]);
                Pf[s] = __builtin_bit_cast(bf16x8, w); }
#pragma unroll
            for (int db = 0; db < 4; ++db)
#pragma unroll
                for (int s = 0; s < 4; ++s) { const LAS unsigned char* vp = Vl + (32 * db + ql) * AT_VROW + (16 * s + 4 * hf) * 2;
                    const u32x2 lo = *(const LAS u32x2*)vp, hi = *(const LAS u32x2*)(vp + 16);
                    const u32x4 a4 = {lo.x, lo.y, hi.x, hi.y};
                    O[db] = __builtin_amdgcn_mfma_f32_32x32x16_bf16(__builtin_bit_cast(bf16x8, a4), Pf[s], O[db], 0, 0, 0); }
            nd = needc - m;
            nd = fmaxf(nd, dppf<0xB1>(nd)); nd = fmaxf(nd, dppf<0x4E>(nd)); nd = fmaxf(nd, dppf<0x141>(nd)); nd = fmaxf(nd, dppf<0x140>(nd));
            nd = fmaxf(nd, __shfl_xor(nd, 16)); nd = fmaxf(nd, __shfl_xor(nd, 32));
        }
        if (lane == 0) needw[(it & 1) * 8 + wave] = nd;
        if (more) AT_WRITE(b ^ 1);
        __syncthreads();
        if (!more) break;
    }
    l += __shfl_xor(l, 32);
    const float inv = 1.0f / l;
#pragma unroll
    for (int db = 0; db < 4; ++db)
#pragma unroll
        for (int i4 = 0; i4 < 4; ++i4) { const int d = 32 * db + 8 * i4 + 4 * hf;
            const u32x2 g = *(const u32x2*)(P + (size_t)q * NP + COL_GB + h * 128 + d);
            const float o0 = O[db][4 * i4 + 0] * inv * siluf_(bflo(g.x)), o1 = O[db][4 * i4 + 1] * inv * siluf_(bfhi(g.x));
            const float o2 = O[db][4 * i4 + 2] * inv * siluf_(bflo(g.y)), o3 = O[db][4 * i4 + 3] * inv * siluf_(bfhi(g.y));
            u32x2 w; w.x = cvt_pk_bf16(o0, o1); w.y = cvt_pk_bf16(o2, o3);
            *(u32x2*)(Yb + (size_t)q * DBR + h * 128 + d) = w; }
#undef AT_LOAD
#undef AT_WRITE
}

#ifndef P4S
#define P4SEL(n) 1
#else
#define P4SEL(n) (P4S == (n))
#endif
#ifndef PH
#define PHSEL(n) 1
#else
#define PHSEL(n) ((PH) >= 100 ? ((n) != (PH) - 100) : (PH) == (n))
#endif
#ifndef REPRW
#define REPRW 1
#endif
#ifndef REP2
#define REP2 1
#endif
#ifndef REP3
#define REP3 1
#endif
#ifndef REP4
#define REP4 1
#endif
#ifndef REP5
#define REP5 1
#endif
typedef __attribute__((address_space(4))) const Params* KP;
#define KP_FRESH(kp) KP kp = (KP)__builtin_amdgcn_kernarg_segment_ptr(); asm volatile("" : "+s"(kp))

__global__ void __launch_bounds__(512) hybrid_fwd(Params p_unused) {
    extern __shared__ __attribute__((aligned(16))) unsigned char lds_raw[];
    LAS unsigned char* lds = (LAS unsigned char*)lds_raw;
    cg::grid_group grid = cg::this_grid();
    const int G = gridDim.x, bid = blockIdx.x, NGW = G * 8;
    if (threadIdx.x < 2) ((volatile LAS unsigned*)(lds + XB_ST_OFF))[threadIdx.x] = 0u;
    { KP_FRESH(kpb); unsigned* ctl0 = (unsigned*)(kpb->ws + OFF_CTL);
      for (int w = bid * 512 + (int)threadIdx.x; w < CW_XBAR + XCD_BAR_WORDS; w += G * 512) ctl0[w] = 0u; }
    __syncthreads();
#define GRID_BAR() do { KP_FRESH(kpb_); XcdBarrier b_; b_.bar = (unsigned*)(kpb_->ws + OFF_CTL) + CW_XBAR; b_.x = xb_xcc_id(); b_.st = (volatile LAS unsigned*)(lds + XB_ST_OFF); xcd_barrier(b_); } while (0)
#define TID_FRESH() const int tid = fresh_tid(), lane = tid & 63, wave = __builtin_amdgcn_readfirstlane(tid >> 6), gw = bid * 8 + wave; (void)lane; (void)gw

#if PHSEL(0)
    {
        KP_FRESH(kp); TID_FRESH();
        unsigned char* ws = kp->ws;
        LAS float* scr = (LAS float*)(lds + wave * 16384);
        convert_win(kp->in[3], (bf16_t*)(ws + OFF_WIN), scr, gw, NGW, lane);
#pragma unroll 1
        for (int l = 0; l < 2; ++l) {
            bf16_t* WBR = (bf16_t*)(ws + OFF_WSM + l * SZ_WSM_L); bf16_t* WOUT = (bf16_t*)((unsigned char*)WBR + SZ_WBR); bf16_t* WGT = (bf16_t*)((unsigned char*)WOUT + SZ_WOUT);
#pragma unroll 1
            for (int z = 0; z < 3; ++z) { const float* src = kp->in[21] + (size_t)(l * 3 + z) * DBR * DM;
                for (int it = gw; it < (DBR / 64) * (DM / 32); it += NGW) transpose_item<false>(src, DBR, DM, WBR + (size_t)z * DM * DBR, scr, it, DM / 32, lane); }
            { const float* src = kp->in[22] + (size_t)l * DM * DM;
                for (int it = gw; it < (DM / 64) * (DM / 32); it += NGW) transpose_item<false>(src, DM, DM, WOUT, scr, it, DM / 32, lane); }
            { bf16_t* WL = (bf16_t*)((unsigned char*)WGT + SZ_WGT); const float* wu = kp->in[13] + (size_t)l * 64 * DBR; const float* au = kp->in[15] + (size_t)l * 64 * DBR;
                for (int e = bid * 512 + tid; e < DBR * 64; e += G * 512) { const int k = e & 63, c = e >> 6; WL[e] = (bf16_t)f2bf(wu[(size_t)k * DBR + c]); WL[(size_t)DBR * 64 + e] = (bf16_t)f2bf(au[(size_t)k * DBR + c]); } }
            { const float* src = kp->in[7] + (size_t)l * 2 * 16 * 64 * 64;
                for (int e = bid * 512 + tid; e < 2 * 16 * 64 * 64; e += G * 512) { const int i = e & 63, j = (e >> 6) & 63, gh = e >> 12; WGT[e] = (bf16_t)f2bf(src[(size_t)gh * 4096 + i * 64 + j]); } }
        }
        const float* x = kp->in[0]; const float* pre = kp->in[1]; bf16_t* H = (bf16_t*)(ws + OFF_HY);
#pragma unroll 2
        for (int row = gw; row < S_; row += NGW) {
            const f32x4* xr = (const f32x4*)(x + (size_t)row * DM) + lane; f32x4 v[8]; float s = 0.f;
#pragma unroll
            for (int j = 0; j < 8; ++j) { v[j] = xr[64 * j]; s += (v[j][0] * v[j][0] + v[j][1] * v[j][1]) + (v[j][2] * v[j][2] + v[j][3] * v[j][3]); }
            rms_row_store(v, wave_sum(s), pre, H + (size_t)row * DM, lane);
        }
    }
#endif
    grid.sync();
    { KP_FRESH(kpb); if (threadIdx.x == 0) (void)xb_add((unsigned*)(kpb->ws + OFF_CTL) + CW_XBAR + XB_XCNT(xb_xcc_id()), 1u); }

#pragma unroll 1
    for (int l = 0; l < 2; ++l) {
        { KP_FRESH(kp); TID_FRESH(); unsigned char* ws = kp->ws;
          pg8::Gemm g{(const bf16_t*)(ws + OFF_HY), (const bf16_t*)(ws + OFF_WIN), S_, NA, DM, 0, 0}; pg8::StaticOrder so; so.init(S_, NA, G, bid, 1);
          pg8::EpiStore E{(bf16_t*)(ws + OFF_P), NP};
          pg8::gemm_phase<pg8::EpiStore>(lds, g, so, E); }
        GRID_BAR();
        {
            KP_FRESH(kp); TID_FRESH(); unsigned char* ws = kp->ws;
            const bf16_t* P = (const bf16_t*)(ws + OFF_P);
            const bf16_t* wlora = (const bf16_t*)(ws + OFF_WSM + l * SZ_WSM_L + SZ_WBR + SZ_WOUT + SZ_WGT);
            RwkvW rw{kp->in[11] + (size_t)l * 3200, kp->in[12] + (size_t)l * DBR, kp->in[14] + (size_t)l * DBR, kp->in[16] + (size_t)l * DBR, kp->in[17] + (size_t)l * DBR, kp->in[18] + (size_t)l * DBR, wlora, wlora + (size_t)DBR * 64};
            float* DEC = (float*)(ws + OFF_RW); bf16_t* RKK = (bf16_t*)(ws + OFF_RW + SZ_DEC);
            for (int u = bid; u < S_ / 16; u += G)
                rwkv_prep_unit(lds, P, rw, DEC, RKK, RKK + (size_t)S_ * DBR, RKK + (size_t)2 * S_ * DBR, RKK + (size_t)3 * S_ * DBR, RKK + (size_t)4 * S_ * DBR, (float*)(ws + OFF_BON), u, tid);
        }
        GRID_BAR();
        {
            const unsigned GB = (unsigned)(G - N_RWKV_BLK);
            if (bid < N_RWKV_BLK) {
                { KP_FRESH(kp); TID_FRESH(); unsigned char* ws = kp->ws;
                  const bf16_t* RKK = (const bf16_t*)(ws + OFF_RW + SZ_DEC);
                  for (int rr_ = 0; rr_ < REPRW; ++rr_) rwkv_seq(lds, (const float*)(ws + OFF_RW), RKK, RKK + (size_t)S_ * DBR, RKK + (size_t)2 * S_ * DBR, RKK + (size_t)3 * S_ * DBR, RKK + (size_t)4 * S_ * DBR, (float*)(ws + OFF_YRAW), bid, tid); }
                { KP_FRESH(kp); part_wait((unsigned*)(kp->ws + OFF_CTL) + CW_PB + 64 * l, 2 * GB); }
            } else {
                { KP_FRESH(kp); TID_FRESH(); unsigned char* ws = kp->ws;
                  pg8::Gemm g{(const bf16_t*)(ws + OFF_HY), (const bf16_t*)(ws + OFF_WIN) + (size_t)NA * DM, S_, NP - NA, DM, 0, 0}; pg8::StaticOrder so; so.init(S_, NP - NA, (int)GB, bid - N_RWKV_BLK, 1);
                  pg8::EpiStoreGate E{(bf16_t*)(ws + OFF_P) + NA, NP, (COL_MG - NA) / 256, kp->in[4] + (size_t)l * 3 * DM};
                  pg8::gemm_phase<pg8::EpiStoreGate>(lds, g, so, E); }
                { KP_FRESH(kp); part_barrier((unsigned*)(kp->ws + OFF_CTL) + CW_PB + 64 * l, GB); }
                { KP_FRESH(kp); TID_FRESH(); unsigned char* ws = kp->ws;
                  const bf16_t* P = (const bf16_t*)(ws + OFF_P);
                  constexpr int NU_VT = (S_ / 64) * 8, NU_LRU = 16 * (S_ / 64);
                  LruW lw{kp->in[5] + (size_t)l * 4 * DBR, kp->in[6] + (size_t)l * DBR, kp->in[8] + (size_t)l * 2 * DBR, kp->in[9] + (size_t)l * DBR, (const bf16_t*)(ws + OFF_WSM + l * SZ_WSM_L + SZ_WBR + SZ_WOUT)};
                  for (int u = bid - N_RWKV_BLK; u < NU_VT + NU_LRU; u += (int)GB) {
                      if (u >= NU_VT) lru_chunk_unit(lds, P, lw, (bf16_t*)(ws + OFF_HY), (bf16_t*)(ws + OFF_ACUM), (float*)(ws + OFF_AGA), (float*)(ws + OFF_AGB), u - NU_VT, tid);
                      else vt_unit(lds, P, (bf16_t*)(ws + OFF_VT), kp->in[10] + l * 8, (float*)(ws + OFF_C), (float*)(ws + OFF_TS), (unsigned*)(ws + OFF_CTL) + CW_KN + 64 * l, u, tid);
                  } }
                { KP_FRESH(kp); part_barrier((unsigned*)(kp->ws + OFF_CTL) + CW_PB + 64 * l, 2 * GB); }
                if (bid == N_RWKV_BLK) { KP_FRESH(kp); TID_FRESH(); unsigned char* ws = kp->ws;
                    const float* AGA = (const float*)(ws + OFF_AGA); const float* AGB = (const float*)(ws + OFF_AGB); float* CIN = (float*)(ws + OFF_CIN);
#pragma unroll
                    for (int cc = 0; cc < 2; ++cc) { const int c = tid + 512 * cc; float carry = 0.f;
#pragma unroll 8
                        for (int ci = 0; ci < S_ / 64; ++ci) { CIN[(size_t)ci * DBR + c] = carry; carry = AGA[(size_t)ci * DBR + c] * carry + AGB[(size_t)ci * DBR + c]; } }
                }
            }
            { KP_FRESH(kp); TID_FRESH(); unsigned char* ws = kp->ws;
            LAS int* sh = (LAS int*)(lds + 144 * 1024 - 64);
            unsigned* ctr = (unsigned*)(ws + OFF_CTL) + CW_ATTN + 64 * l;
            for (;;) {
                __syncthreads();
                if (tid == 0) *sh = (int)atomicAdd(ctr, 1u);
                __syncthreads();
                const int u = *sh;
                if (u >= 512) break;
                attn_unit(lds, (const bf16_t*)(ws + OFF_P), (const bf16_t*)(ws + OFF_VT), (const float*)(ws + OFF_C), (const float*)(ws + OFF_TS), (const unsigned*)(ws + OFF_CTL) + CW_KN + 64 * l, (bf16_t*)(ws + OFF_HY) + (size_t)S_ * DBR, u & 7, 63 - (u >> 3), tid);
            } }
        }
        GRID_BAR();
#if PHSEL(5)
        {
            KP_FRESH(kp); TID_FRESH(); unsigned char* ws = kp->ws;
            bf16_t* Yc = (bf16_t*)(ws + OFF_HY) + (size_t)2 * S_ * DBR; bf16_t* Ya = (bf16_t*)(ws + OFF_HY);
            const bf16_t* ACUM = (const bf16_t*)(ws + OFF_ACUM); const float* CIN = (const float*)(ws + OFF_CIN);
            const float* YRAW = (const float*)(ws + OFF_YRAW); const float* BON = (const float*)(ws + OFF_BON);
            const bf16_t* RV = (const bf16_t*)(ws + OFF_RW + SZ_DEC) + (size_t)4 * S_ * DBR; const bf16_t* P = (const bf16_t*)(ws + OFF_P);
            const int q4 = (tid & 255) * 4, hh = q4 >> 6;
            const f32x4 lnw = *(const f32x4*)(kp->in[19] + (size_t)l * DBR + q4), lnb = *(const f32x4*)(kp->in[20] + (size_t)l * DBR + q4);
#pragma unroll 8
            for (int t = bid * 2 + (tid >> 8); t < S_; t += 2 * G) {
                const size_t o = (size_t)t * DBR + q4;
                const f32x4 y = *(const f32x4*)(YRAW + o);
                const u32x2 rv = *(const u32x2*)(RV + o), gc = *(const u32x2*)(P + (size_t)t * NP + COL_GC + q4), ga = *(const u32x2*)(P + (size_t)t * NP + COL_GA + q4);
                const u32x2 hl = *(const u32x2*)(Ya + o), ac = *(const u32x2*)(ACUM + o);
                const f32x4 cin = *(const f32x4*)(CIN + (size_t)(t >> 6) * DBR + q4);
                const float bon = BON[(size_t)t * 16 + hh];
                const float mu = rowsum16((y[0] + y[1]) + (y[2] + y[3])) * (1.0f / 64.0f);
                const f32x4 d = y - mu;
                const float var = rowsum16((d[0] * d[0] + d[1] * d[1]) + (d[2] * d[2] + d[3] * d[3])) * (1.0f / 64.0f);
                const float rs = 1.0f / sqrtf(var + GN_EPS);
                const float y0 = (d[0] * rs * lnw[0] + lnb[0] + bon * bflo(rv.x)) * siluf_(bflo(gc.x)), y1 = (d[1] * rs * lnw[1] + lnb[1] + bon * bfhi(rv.x)) * siluf_(bfhi(gc.x));
                const float y2 = (d[2] * rs * lnw[2] + lnb[2] + bon * bflo(rv.y)) * siluf_(bflo(gc.y)), y3 = (d[3] * rs * lnw[3] + lnb[3] + bon * bfhi(rv.y)) * siluf_(bfhi(gc.y));
                u32x2 w; w.x = cvt_pk_bf16(y0, y1); w.y = cvt_pk_bf16(y2, y3);
                *(u32x2*)(Yc + o) = w;
                const float h0 = (bflo(hl.x) + bflo(ac.x) * cin[0]) * siluf_(bflo(ga.x)), h1 = (bfhi(hl.x) + bfhi(ac.x) * cin[1]) * siluf_(bfhi(ga.x));
                const float h2 = (bflo(hl.y) + bflo(ac.y) * cin[2]) * siluf_(bflo(ga.y)), h3 = (bfhi(hl.y) + bfhi(ac.y) * cin[3]) * siluf_(bfhi(ga.y));
                u32x2 w2; w2.x = cvt_pk_bf16(h0, h1); w2.y = cvt_pk_bf16(h2, h3);
                *(u32x2*)(Ya + o) = w2;
            }
        }
#endif
        GRID_BAR();
#if PHSEL(6)
        for (int rep = 0; rep < REP5; ++rep) { if (rep) GRID_BAR(); KP_FRESH(kp); TID_FRESH(); unsigned char* ws = kp->ws;
          pg8::Gemm g{(const bf16_t*)(ws + OFF_HY), (const bf16_t*)(ws + OFF_WSM + l * SZ_WSM_L), S_, DM, DBR, (size_t)S_ * DBR * 2, (size_t)DM * DBR * 2}; pg8::StaticOrder so; so.init(S_, DM, G, bid, 3);
          pg8::EpiMerge E{(bf16_t*)(ws + OFF_M), (const bf16_t*)(ws + OFF_P)};
          pg8::gemm_phase<pg8::EpiMerge, true>(lds, g, so, E); }
#endif
        GRID_BAR();
#if PHSEL(7)
        { KP_FRESH(kp); TID_FRESH(); unsigned char* ws = kp->ws;
          pg8::Gemm g{(const bf16_t*)(ws + OFF_M), (const bf16_t*)(ws + OFF_WSM + l * SZ_WSM_L + SZ_WBR), S_, DM, DM, 0, 0}; pg8::StaticOrder so; so.init(S_, DM, G, bid, 1);
          pg8::EpiOut E{(bf16_t*)(ws + OFF_MO), (float*)(ws + OFF_CTL) + CW_ROWSS + l * S_};
          pg8::gemm_phase<pg8::EpiOut>(lds, g, so, E); }
#endif
        GRID_BAR();
#if PHSEL(8)
        {
            KP_FRESH(kp); TID_FRESH(); unsigned char* ws = kp->ws;
            float* outp = kp->out;
            const float* xin = (l == 0) ? kp->in[0] : outp;
            const float* pw = kp->in[2] + (size_t)l * DM;
            const float* pre1 = kp->in[1] + DM;
            const float* rowss = (const float*)(ws + OFF_CTL) + CW_ROWSS + l * S_;
            const bf16_t* MO = (const bf16_t*)(ws + OFF_MO); bf16_t* H = (bf16_t*)(ws + OFF_HY);
            f32x4 pwv[8];
#pragma unroll
            for (int j = 0; j < 8; ++j) pwv[j] = *((const f32x4*)pw + lane + 64 * j);
#pragma unroll 2
            for (int row = gw; row < S_; row += NGW) {
                const float sc = 1.0f / sqrtf(rowss[row] * (1.0f / DM) + NORM_EPS);
                const f32x4* xr = (const f32x4*)(xin + (size_t)row * DM) + lane; const u32x2* mr = (const u32x2*)(MO + (size_t)row * DM) + lane;
                f32x4* orow = (f32x4*)(outp + (size_t)row * DM) + lane;
                f32x4 v[8]; float s = 0.f;
#pragma unroll
                for (int j = 0; j < 8; ++j) { const f32x4 xv = xr[64 * j]; const u32x2 mw = mr[64 * j]; const f32x4 pv = pwv[j];
                    f32x4 o; o[0] = xv[0] + bflo(mw.x) * sc * pv[0]; o[1] = xv[1] + bfhi(mw.x) * sc * pv[1]; o[2] = xv[2] + bflo(mw.y) * sc * pv[2]; o[3] = xv[3] + bfhi(mw.y) * sc * pv[3];
                    orow[64 * j] = o; v[j] = o; s += (o[0] * o[0] + o[1] * o[1]) + (o[2] * o[2] + o[3] * o[3]); }
                if (l == 0) rms_row_store(v, wave_sum(s), pre1, H + (size_t)row * DM, lane);
            }
            if (l == 0) { __syncthreads(); convert_win(kp->in[3] + (size_t)DM * NIN, (bf16_t*)(ws + OFF_WIN), (LAS float*)(lds + wave * 16384), gw, NGW, lane); }
        }
#endif
        if (l == 0) GRID_BAR();
    }
}

extern "C" void kernel_launch(void* const* d_in, const int* in_sizes, int n_in, void* d_out, int out_size, void* d_ws, size_t ws_size, hipStream_t stream) {
    static int grid = 0;
    if (grid == 0) {
        if (n_in != 23 || out_size != S_ * DM || ws_size < WS_END) { fprintf(stderr, "kernel_launch: unexpected problem (n_in %d, out %d, ws %zu, need %zu)\n", n_in, out_size, ws_size, (size_t)WS_END); grid = -1; return; }
        int dev = 0, cus = 0, per_cu = 0;
        hipGetDevice(&dev);
        hipDeviceGetAttribute(&cus, hipDeviceAttributeMultiprocessorCount, dev);
        if (hipFuncSetAttribute((const void*)hybrid_fwd, hipFuncAttributeMaxDynamicSharedMemorySize, LDS_BYTES) != hipSuccess) { fprintf(stderr, "kernel_launch: hipFuncSetAttribute failed\n"); grid = -1; return; }
        hipOccupancyMaxActiveBlocksPerMultiprocessor(&per_cu, (const void*)hybrid_fwd, 512, LDS_BYTES);
        (void)hipGetLastError();
        if (per_cu < 1) per_cu = 1;
        grid = cus * per_cu;
        if (grid < N_RWKV_BLK + 8) { fprintf(stderr, "kernel_launch: grid %d too small\n", grid); grid = -1; return; }
    }
    if (grid < 0) return;
    Params p{};
    for (int i = 0; i < 23; ++i) p.in[i] = (const float*)d_in[i];
    p.out = (float*)d_out; p.ws = (unsigned char*)d_ws;
    void* args[] = {&p};
    hipError_t e = hipLaunchCooperativeKernel((const void*)hybrid_fwd, dim3(grid), dim3(512), args, LDS_BYTES, stream);
    if (e != hipSuccess) fprintf(stderr, "kernel_launch: cooperative launch failed: %s (grid %d)\n", hipGetErrorString(e), grid);
}
```

```cpp
#include <hip/hip_runtime.h>
#include <hip/hip_cooperative_groups.h>
#include <cstdio>
#include <cstdint>
namespace cg = cooperative_groups;

#define LAS __attribute__((address_space(3)))
typedef unsigned short bf16_t;
typedef short bf16x8 __attribute__((ext_vector_type(8)));
typedef float f32x2 __attribute__((ext_vector_type(2)));
typedef float f32x4 __attribute__((ext_vector_type(4)));
typedef float f32x16 __attribute__((ext_vector_type(16)));
typedef unsigned u32x2 __attribute__((ext_vector_type(2)));
typedef unsigned u32x4 __attribute__((ext_vector_type(4)));

constexpr int S_ = 16384, DM = 2048, NP = 16640, NIN = 16520, DBR = 1024;
constexpr int COL_PC = 0, COL_FL = 3200, COL_GC = 3328, COL_XA = 4352, COL_GA = 5376, COL_Q = 6400, COL_K = 7424, COL_V = 8448, COL_GB = 9472, COL_MG = 10496;
constexpr int NA = 3328;
constexpr int NFILL = 768;
constexpr float NORM_EPS = 1e-6f, GN_EPS = 64e-5f, LOG2E = 1.4426950408889634f;
constexpr int LDS_BYTES = 147456;
constexpr int N_RWKV_BLK = 64;

constexpr size_t OFF_CTL = 0, CTL_BYTES = 1u << 20;
constexpr size_t OFF_P = CTL_BYTES;
constexpr size_t SZ_P = (size_t)S_ * NP * 2;
constexpr size_t OFF_WIN = OFF_P + SZ_P;
constexpr size_t SZ_WIN = (size_t)NP * DM * 2;
constexpr size_t OFF_VT = OFF_WIN;
constexpr size_t OFF_C = OFF_WIN + (size_t)8 * 128 * S_ * 2;
constexpr size_t OFF_WSM = OFF_WIN + SZ_WIN;
constexpr size_t SZ_WBR = (size_t)3 * DM * DBR * 2, SZ_WOUT = (size_t)DM * DM * 2, SZ_WGT = (size_t)2 * 16 * 64 * 64 * 2;
constexpr size_t SZ_WLORA = (size_t)2 * DBR * 64 * 2;
constexpr size_t SZ_WSM_L = SZ_WBR + SZ_WOUT + SZ_WGT + SZ_WLORA;
constexpr size_t OFF_HY = OFF_WSM + 2 * SZ_WSM_L;
constexpr size_t SZ_Y1 = (size_t)S_ * DBR * 2;
constexpr size_t OFF_RW = OFF_HY + 3 * SZ_Y1;
constexpr size_t SZ_DEC = (size_t)S_ * DBR * 4;
constexpr size_t OFF_M = OFF_RW, OFF_MO = OFF_RW + (size_t)S_ * DM * 2;
constexpr size_t OFF_BON = OFF_RW + SZ_DEC + 5 * SZ_Y1;
constexpr size_t OFF_YRAW = OFF_BON + (size_t)S_ * 16 * 4;
constexpr size_t OFF_AGA = OFF_YRAW + (size_t)S_ * DBR * 4;
constexpr size_t OFF_AGB = OFF_AGA + (1u << 20);
constexpr size_t OFF_CIN = OFF_AGB + (1u << 20);
constexpr size_t OFF_TS = OFF_CIN + (1u << 20);
constexpr size_t WS_END = OFF_TS + (1u << 16);
constexpr size_t OFF_ACUM = OFF_C + (size_t)8 * S_ * 4;
static_assert(OFF_ACUM + (size_t)S_ * DBR * 2 <= OFF_WSM, "ACUM fits behind VT and C");
constexpr int CW_ATTN = 0;
constexpr int CW_ROWSS = 4096;
constexpr int CW_KN = 3072;
constexpr int CW_PB = 2048;

__device__ __forceinline__ float bf2f(unsigned b) { return __uint_as_float(b << 16); }
__device__ __forceinline__ float bflo(unsigned w) { return __uint_as_float(w << 16); }
__device__ __forceinline__ float bfhi(unsigned w) { return __uint_as_float(w & 0xffff0000u); }
__device__ __forceinline__ unsigned f2bf(float f) { unsigned u = __float_as_uint(f); return (u + 0x7fffu + ((u >> 16) & 1u)) >> 16; }
__device__ __forceinline__ unsigned pk2(float lo, float hi) { return f2bf(lo) | (f2bf(hi) << 16); }
__device__ __forceinline__ unsigned cvt_pk_bf16(float lo, float hi) { unsigned r; asm volatile("v_cvt_pk_bf16_f32 %0, %1, %2" : "=v"(r) : "v"(lo), "v"(hi)); return r; }
__device__ __forceinline__ float sigmoidf_(float x) { return 1.0f / (1.0f + __expf(-x)); }
__device__ __forceinline__ float siluf_(float x) { return x / (1.0f + __expf(-x)); }
__device__ __forceinline__ float softplusf_(float x) { return fmaxf(x, 0.f) + log1pf(expf(-fabsf(x))); }
__device__ __forceinline__ float logsigf_(float x) { return fminf(x, 0.f) - log1pf(expf(-fabsf(x))); }
__device__ __forceinline__ int fresh_tid() { int t = threadIdx.x; asm volatile("" : "+v"(t)); return t; }
#define LDS_WAIT() asm volatile("s_waitcnt lgkmcnt(0)" ::: "memory")
template <int CTRL> __device__ __forceinline__ float dppf(float x) { return __int_as_float(__builtin_amdgcn_update_dpp(0, __float_as_int(x), CTRL, 0xf, 0xf, true)); }
__device__ __forceinline__ float rowsum16(float x) {
    x += dppf<0xB1>(x); x += dppf<0x4E>(x); x += dppf<0x141>(x); x += dppf<0x140>(x); return x;
}

__device__ __forceinline__ float wave_sum(float v) { v = rowsum16(v); v += __shfl_xor(v, 16); v += __shfl_xor(v, 32); return v; }

__device__ __forceinline__ void part_barrier(unsigned* ctr, unsigned target) {
    asm volatile("s_waitcnt vmcnt(0)" ::: "memory");
    __syncthreads();
    if (threadIdx.x == 0) {
        __threadfence();
        __hip_atomic_fetch_add(ctr, 1u, __ATOMIC_RELEASE, __HIP_MEMORY_SCOPE_AGENT);
        while (__hip_atomic_load(ctr, __ATOMIC_ACQUIRE, __HIP_MEMORY_SCOPE_AGENT) < target) __builtin_amdgcn_s_sleep(2);
        __threadfence();
    }
    __syncthreads();
}
__device__ __forceinline__ void part_wait(unsigned* ctr, unsigned target) {
    __syncthreads();
    if (threadIdx.x == 0) { while (__hip_atomic_load(ctr, __ATOMIC_ACQUIRE, __HIP_MEMORY_SCOPE_AGENT) < target) __builtin_amdgcn_s_sleep(2); __threadfence(); }
    __syncthreads();
}


#define XB_TMO      128
#define XB_XCNT(j)  (256  + 64 * (j))
#define XB_XSUB(j)  (1280 + 64 * (j))
#define XB_XGEN(j)  (2304 + 64 * (j))
#define XB_TOP      3328
#define XB_TOPGEN   3392
#define XCD_BAR_WORDS 3456
#define XB_SPIN_CAP (1u << 22)
__device__ __forceinline__ unsigned xb_ld(unsigned* p)              { return __hip_atomic_load(p, __ATOMIC_RELAXED, __HIP_MEMORY_SCOPE_AGENT); }
__device__ __forceinline__ unsigned xb_add(unsigned* p, unsigned v) { return __hip_atomic_fetch_add(p, v, __ATOMIC_RELAXED, __HIP_MEMORY_SCOPE_AGENT); }
__device__ __forceinline__ unsigned xb_xcc_id() { return (unsigned)__builtin_amdgcn_s_getreg((3 << 11) | 20) & 0xFu; }
#define XB_SPIN(cond, bar) do { unsigned _sp = 0; while (cond) { __builtin_amdgcn_s_sleep(1); \
    if ((++_sp & 255u) == 0u) { if (xb_ld(&(bar)[XB_TMO])) break; if (_sp > XB_SPIN_CAP) { atomicAdd(&(bar)[XB_TMO], 1u); break; } } } } while (0)
struct XcdBarrier { unsigned* bar; unsigned x; volatile LAS unsigned* st; };
__device__ __forceinline__ void xcd_barrier_complete(unsigned* bar, unsigned x, unsigned& nloc, unsigned& nx) {
    const unsigned G = gridDim.x * gridDim.y * gridDim.z;
    unsigned sum, cnt, mine, sp = 0u;
    for (;;) {
        sum = 0u; cnt = 0u; mine = 0u;
#pragma unroll
        for (unsigned j = 0; j < 16; ++j) { const unsigned c = xb_ld(&bar[XB_XCNT(j)]); sum += c; cnt += (c > 0u) ? 1u : 0u; mine = (j == x) ? c : mine; }
        if (sum == G) break;
        __builtin_amdgcn_s_sleep(1);
        if ((++sp & 255u) == 0u) { if (xb_ld(&bar[XB_TMO])) break; if (sp > XB_SPIN_CAP) { atomicAdd(&bar[XB_TMO], 1u); break; } }
    }
    nloc = mine > 0u ? mine : 1u; nx = cnt > 0u ? cnt : 1u;
}
__device__ __forceinline__ void xcd_barrier(const XcdBarrier& b) {
    asm volatile("s_waitcnt vmcnt(0)" ::: "memory");
    __syncthreads();
    if (threadIdx.x == 0) {
        unsigned* bar = b.bar;
        __builtin_amdgcn_s_waitcnt(0);
        unsigned nloc = b.st[0], nx = b.st[1];
        if (nloc == 0u) { xcd_barrier_complete(bar, b.x, nloc, nx); b.st[0] = nloc; b.st[1] = nx; }
        const unsigned old = xb_add(&bar[XB_XSUB(b.x)], 1u);
        const unsigned gen = old / nloc;
        if (old + 1u == (gen + 1u) * nloc) {
            __builtin_amdgcn_fence(__ATOMIC_RELEASE, "agent");
            asm volatile("s_waitcnt vmcnt(0)" ::: "memory");
            const unsigned og = xb_add(&bar[XB_TOP], 1u);
            const unsigned tg = og / nx;
            if (og + 1u == (tg + 1u) * nx) xb_add(&bar[XB_TOPGEN], 1u);
            else XB_SPIN(xb_ld(&bar[XB_TOPGEN]) == tg, bar);
            __builtin_amdgcn_fence(__ATOMIC_ACQUIRE, "agent");
            xb_add(&bar[XB_XGEN(b.x)], 1u);
            asm volatile("s_waitcnt vmcnt(0)" ::: "memory");
        } else {
            XB_SPIN(xb_ld(&bar[XB_XGEN(b.x)]) == gen, bar);
            __builtin_amdgcn_fence(__ATOMIC_ACQUIRE, "agent");
            asm volatile("s_waitcnt vmcnt(0)" ::: "memory");
        }
    }
    __syncthreads();
}
constexpr int CW_XBAR = 40960;
constexpr int XB_ST_OFF = 144 * 1024 - 32;

namespace pg8 {
constexpr int BM = 256, BK = 64, HALF = 128, HTB = HALF * BK * 2, STAGE_BYTES = 8 * HTB, NXCD = 8, WGM = 8;
__host__ __device__ __forceinline__ int lds_byte(int r, int c) { const int st = (r >> 4) * 2 + (c >> 5), rr = r & 15, cc = c & 31, ob = rr * 64 + cc * 2; return st * 1024 + (ob ^ (((ob >> 9) & 1) << 5)); }
__host__ __device__ __forceinline__ void stage_rc(int b, int& R, int& C) { const int st = b / 1024, sb = b % 1024, swz = sb ^ (((sb >> 9) & 1) << 5); R = (st >> 1) * 16 + swz / 64; C = (st & 1) * 32 + (swz % 64) / 2; }
__host__ __device__ __forceinline__ int perm32(int rho) { const int n = rho >> 4, i = rho & 15; return 8 * (i >> 2) + 4 * n + (i & 3); }

struct Unit { int pm, pn, z; };
struct Gemm { const bf16_t* A; const bf16_t* Bt; int M, N, K; size_t zA, zB; };

struct StaticOrder {
    int nM, nN, nwg, G, c, nz;
    __device__ void init(int M, int N, int G_, int c_, int nz_) { nM = M / BM; nN = N / BM; nwg = nM * nN; G = G_; c = c_; nz = nz_; }
    __device__ bool next(int i, Unit& u) const {
        const int ti = i / nz; u.z = i - ti * nz;
        const long L = (long)ti * G + c; if (L >= nwg) return false;
        int wgid = (int)L; { const int q = nwg / NXCD, r = nwg % NXCD, xcd = wgid % NXCD, off = wgid / NXCD; wgid = (xcd < r ? xcd * (q + 1) : r * (q + 1) + (xcd - r) * q) + off; }
        const int nig = WGM * nN, gid = wgid / nig, fm = gid * WGM, gsz = (nM - fm) < WGM ? (nM - fm) : WGM;
        u.pm = fm + ((wgid % nig) % gsz); u.pn = (wgid % nig) / gsz; return true;
    }
};

struct EpiStore {
    bf16_t* O; int ldc;
    __device__ __forceinline__ void operator()(const f32x4 (&acc)[2][2][4][2], const Unit& u, int wr, int wc, int fr, int fq) const {
        const int row0 = u.pm * BM + wr * 64 + fr, col0 = u.pn * BM + wc * 32 + 8 * fq;
#pragma unroll
        for (int ai = 0; ai < 2; ++ai)
#pragma unroll
            for (int m = 0; m < 4; ++m) { bf16_t* rowp = O + (size_t)(row0 + ai * HALF + m * 16) * ldc + col0;
#pragma unroll
                for (int bj = 0; bj < 2; ++bj) { const f32x4 v0 = acc[ai][bj][m][0], v1 = acc[ai][bj][m][1];
                    u32x4 w; w.x = cvt_pk_bf16(v0[0], v0[1]); w.y = cvt_pk_bf16(v0[2], v0[3]); w.z = cvt_pk_bf16(v1[0], v1[1]); w.w = cvt_pk_bf16(v1[2], v1[3]);
                    *(u32x4*)(rowp + bj * HALF) = w; } }
    }
};
struct EpiStoreGate {
    bf16_t* O; int ldc; int tile0; const float* bmerge;
    __device__ __forceinline__ void operator()(const f32x4 (&acc)[2][2][4][2], const Unit& u, int wr, int wc, int fr, int fq) const {
        const int row0 = u.pm * BM + wr * 64 + fr, col0 = u.pn * BM + wc * 32 + 8 * fq;
        const bool gate = u.pn >= tile0;
#pragma unroll
        for (int bj = 0; bj < 2; ++bj) {
            f32x4 b0 = {0.f, 0.f, 0.f, 0.f}, b1 = {0.f, 0.f, 0.f, 0.f};
            if (gate) { const float* bp = bmerge + (u.pn - tile0) * BM + wc * 32 + 8 * fq + bj * HALF; b0 = *(const f32x4*)bp; b1 = *(const f32x4*)(bp + 4); }
#pragma unroll
            for (int ai = 0; ai < 2; ++ai)
#pragma unroll
                for (int m = 0; m < 4; ++m) { bf16_t* rowp = O + (size_t)(row0 + ai * HALF + m * 16) * ldc + col0 + bj * HALF;
                    f32x4 v0 = acc[ai][bj][m][0], v1 = acc[ai][bj][m][1];
                    if (gate) { v0 = v0 + b0; v1 = v1 + b1;
                        v0[0] = sigmoidf_(v0[0]); v0[1] = sigmoidf_(v0[1]); v0[2] = sigmoidf_(v0[2]); v0[3] = sigmoidf_(v0[3]);
                        v1[0] = sigmoidf_(v1[0]); v1[1] = sigmoidf_(v1[1]); v1[2] = sigmoidf_(v1[2]); v1[3] = sigmoidf_(v1[3]); }
                    u32x4 w; w.x = cvt_pk_bf16(v0[0], v0[1]); w.y = cvt_pk_bf16(v0[2], v0[3]); w.z = cvt_pk_bf16(v1[0], v1[1]); w.w = cvt_pk_bf16(v1[2], v1[3]);
                    *(u32x4*)rowp = w; }
        }
    }
};
struct EpiMerge {
    bf16_t* Mo; const bf16_t* P;
    __device__ __forceinline__ void operator()(f32x4 (&acc)[2][2][4][2], const Unit& u, int wr, int wc, int fr, int fq) const {
        const int row0 = u.pm * BM + wr * 64 + fr, col0 = u.pn * BM + wc * 32 + 8 * fq;
        const int z = u.z;
#pragma unroll
        for (int bj = 0; bj < 2; ++bj) {
            const int col = col0 + bj * HALF;
#pragma unroll
            for (int ai = 0; ai < 2; ++ai)
#pragma unroll
                for (int m = 0; m < 4; ++m) {
                    const int row = row0 + ai * HALF + m * 16;
                    const bf16_t* gp = P + (size_t)row * NP + COL_MG + z * DM + col;
                    const u32x4 g = *(const u32x4*)gp;
                    float r[8] = {bflo(g.x), bfhi(g.x), bflo(g.y), bfhi(g.y), bflo(g.z), bfhi(g.z), bflo(g.w), bfhi(g.w)};
#pragma unroll
                    for (int e = 0; e < 8; ++e) r[e] = fmaxf(r[e], 1e-30f);
                    if (z < 2) { const u32x4 h = *(const u32x4*)(gp + DM);
                        const float d[8] = {bflo(h.x), bfhi(h.x), bflo(h.y), bfhi(h.y), bflo(h.z), bfhi(h.z), bflo(h.w), bfhi(h.w)};
#pragma unroll
                        for (int e = 0; e < 8; ++e) r[e] *= __builtin_amdgcn_rcpf(fmaxf(d[e], 1e-30f)); }
                    f32x4& v0 = acc[ai][bj][m][0]; f32x4& v1 = acc[ai][bj][m][1];
                    v0[0] *= r[0]; v0[1] *= r[1]; v0[2] *= r[2]; v0[3] *= r[3]; v1[0] *= r[4]; v1[1] *= r[5]; v1[2] *= r[6]; v1[3] *= r[7];
                    if (z == 2) { u32x4 w; w.x = cvt_pk_bf16(v0[0], v0[1]); w.y = cvt_pk_bf16(v0[2], v0[3]); w.z = cvt_pk_bf16(v1[0], v1[1]); w.w = cvt_pk_bf16(v1[2], v1[3]);
                        *(u32x4*)(Mo + (size_t)row * DM + col) = w; }
                }
        }
    }
};
struct EpiOut {
    bf16_t* O; float* rowss;
    __device__ __forceinline__ void operator()(const f32x4 (&acc)[2][2][4][2], const Unit& u, int wr, int wc, int fr, int fq) const {
        const int row0 = u.pm * BM + wr * 64 + fr, col0 = u.pn * BM + wc * 32 + 8 * fq;
#pragma unroll
        for (int ai = 0; ai < 2; ++ai)
#pragma unroll
            for (int m = 0; m < 4; ++m) { const int row = row0 + ai * HALF + m * 16; bf16_t* rowp = O + (size_t)row * DM + col0; float s = 0.f;
#pragma unroll
                for (int bj = 0; bj < 2; ++bj) { const f32x4 v0 = acc[ai][bj][m][0], v1 = acc[ai][bj][m][1];
                    s += (v0[0] * v0[0] + v0[1] * v0[1]) + (v0[2] * v0[2] + v0[3] * v0[3]) + (v1[0] * v1[0] + v1[1] * v1[1]) + (v1[2] * v1[2] + v1[3] * v1[3]);
                    u32x4 w; w.x = cvt_pk_bf16(v0[0], v0[1]); w.y = cvt_pk_bf16(v0[2], v0[3]); w.z = cvt_pk_bf16(v1[0], v1[1]); w.w = cvt_pk_bf16(v1[2], v1[3]);
                    *(u32x4*)(rowp + bj * HALF) = w; }
                s += __shfl_xor(s, 16); s += __shfl_xor(s, 32);
                if (fq == 0) atomicAdd(rowss + row, s); }
    }
};

template <class Epi, bool KEEP_Z = false>
__device__ __forceinline__ void gemm_phase(LAS unsigned char* lds, const Gemm g, const StaticOrder& S, const Epi& E) {
    const int tid = fresh_tid(), wid = __builtin_amdgcn_readfirstlane(tid >> 6), lane = tid & 63, wr = wid >> 2, wc = wid & 3, fr = lane & 15, fq = lane >> 4;
    const int K = g.K, nt = K / BK;
    unsigned voffA[2], voffB[2];
#pragma unroll
    for (int i = 0; i < 2; ++i) { int R, C; stage_rc(tid * 16 + i * 8192, R, C); const int Rb = (R & ~31) + perm32(R & 31);
        voffA[i] = (unsigned)(R * K + C) * 2u; voffB[i] = (unsigned)(Rb * K + C) * 2u; }
    const size_t kstep = (size_t)(BK * 2);
    const size_t hstep = (size_t)HALF * K * 2;
    const size_t tstep = 2 * hstep;
    const unsigned ldsw = (unsigned)wid * 1024u;
    const int aoff = lds_byte(wr * 64 + fr, fq * 8), boff = lds_byte(wc * 32 + fr, fq * 8);
#define PG8_SA(b, h) (((b) * 2 + (h)) * HTB)
#define PG8_SB(b, h) ((4 + (b) * 2 + (h)) * HTB)
#define PG8_STAGE(bufoff, gbase, voff) do { _Pragma("unroll") for (int _i = 0; _i < 2; ++_i) \
        __builtin_amdgcn_global_load_lds((const unsigned*)((const char*)(gbase) + (voff)[_i]), (LAS unsigned*)(lds + (bufoff) + ldsw + _i * 8192), 16, 0, 0); } while (0)
#define PG8_LDA(dst, b, h) do { _Pragma("unroll") for (int m = 0; m < 4; ++m) _Pragma("unroll") for (int k = 0; k < 2; ++k) dst[m][k] = *(const LAS bf16x8*)(lds + PG8_SA(b, h) + aoff + m * 2048 + k * 1024); } while (0)
#define PG8_LDB(dst, b, h) do { _Pragma("unroll") for (int n = 0; n < 2; ++n) _Pragma("unroll") for (int k = 0; k < 2; ++k) dst[n][k] = *(const LAS bf16x8*)(lds + PG8_SB(b, h) + boff + n * 2048 + k * 1024); } while (0)
#define PG8_MMA(ai, bj, At, Bt) do { __builtin_amdgcn_s_setprio(1); _Pragma("unroll") for (int m = 0; m < 4; ++m) _Pragma("unroll") for (int n = 0; n < 2; ++n) _Pragma("unroll") for (int k = 0; k < 2; ++k) \
        acc[ai][bj][m][n] = __builtin_amdgcn_mfma_f32_16x16x32_bf16(Bt[n][k], At[m][k], acc[ai][bj][m][n], 0, 0, 0); __builtin_amdgcn_s_setprio(0); } while (0)
#define PG8_WAIT_V(n) asm volatile("s_waitcnt vmcnt(" #n ")" ::: "memory")
#define PG8_WAIT_L(n) asm volatile("s_waitcnt lgkmcnt(" #n ")" ::: "memory")
#define PG8_BAR __builtin_amdgcn_s_barrier()
#define PG8_SCHED __builtin_amdgcn_sched_barrier(0)
    Unit cur, nxt; int ui = 0;
    if (!S.next(0, cur)) return;
    f32x4 acc[2][2][4][2];
#pragma unroll
    for (int a = 0; a < 2; ++a)
#pragma unroll
        for (int b = 0; b < 2; ++b)
#pragma unroll
            for (int m = 0; m < 4; ++m)
#pragma unroll
                for (int n = 0; n < 2; ++n) acc[a][b][m][n] = (f32x4){0.f, 0.f, 0.f, 0.f};
    bf16x8 At[4][2], B0[2][2], B1[2][2];
    const char* cA = (const char*)g.A + (size_t)cur.pm * tstep + (size_t)cur.z * g.zA; const char* cB = (const char*)g.Bt + (size_t)cur.pn * tstep + (size_t)cur.z * g.zB;
    {
        PG8_STAGE(PG8_SB(0, 0), cB, voffB); PG8_STAGE(PG8_SB(0, 1), cB + hstep, voffB); PG8_STAGE(PG8_SA(0, 0), cA, voffA); PG8_STAGE(PG8_SA(0, 1), cA + hstep, voffA);
        if (wr == 1) PG8_BAR;
        PG8_WAIT_V(2); PG8_BAR;
        PG8_STAGE(PG8_SB(1, 0), cB + kstep, voffB); PG8_STAGE(PG8_SA(1, 0), cA + kstep, voffA); PG8_STAGE(PG8_SB(1, 1), cB + hstep + kstep, voffB);
        PG8_WAIT_V(6); PG8_BAR;
    }
    for (;;) {
        const bool has_next = S.next(ui + 1, nxt);
        const char* nA = has_next ? (const char*)g.A + (size_t)nxt.pm * tstep + (size_t)nxt.z * g.zA : cA; const char* nB = has_next ? (const char*)g.Bt + (size_t)nxt.pn * tstep + (size_t)nxt.z * g.zB : cB;
        for (int t = 0; t < nt; t += 2) {
            const bool last = (t == nt - 2);
            const char* a1 = cA + (size_t)(t + 1) * kstep;
            const char* a2 = last ? nA : cA + (size_t)(t + 2) * kstep; const char* b2 = last ? nB : cB + (size_t)(t + 2) * kstep;
            const char* a3 = a2 + kstep; const char* b3 = b2 + kstep;
            PG8_LDB(B0, 0, 0); PG8_LDB(B1, 0, 1); PG8_SCHED; PG8_LDA(At, 0, 0); PG8_STAGE(PG8_SA(1, 1), a1 + hstep, voffA);
            PG8_WAIT_V(8); PG8_WAIT_L(0); PG8_BAR; PG8_MMA(0, 0, At, B0); PG8_MMA(0, 1, At, B1); PG8_BAR; PG8_SCHED;
            PG8_LDA(At, 0, 1); PG8_STAGE(PG8_SB(0, 0), b2, voffB); PG8_STAGE(PG8_SB(0, 1), b2 + hstep, voffB); PG8_STAGE(PG8_SA(0, 0), a2, voffA);
            PG8_WAIT_V(8); PG8_WAIT_L(0); PG8_BAR; PG8_MMA(1, 0, At, B0); PG8_MMA(1, 1, At, B1); PG8_BAR; PG8_SCHED;
            PG8_LDB(B0, 1, 0); PG8_LDB(B1, 1, 1); PG8_SCHED; PG8_LDA(At, 1, 0); PG8_STAGE(PG8_SA(0, 1), a2 + hstep, voffA);
            PG8_WAIT_V(8); PG8_WAIT_L(0); PG8_BAR; PG8_MMA(0, 0, At, B0); PG8_MMA(0, 1, At, B1); PG8_BAR; PG8_SCHED;
            PG8_LDA(At, 1, 1); PG8_STAGE(PG8_SB(1, 0), b3, voffB); PG8_STAGE(PG8_SB(1, 1), b3 + hstep, voffB); PG8_STAGE(PG8_SA(1, 0), a3, voffA);
            PG8_WAIT_V(8); PG8_WAIT_L(0); PG8_BAR; PG8_MMA(1, 0, At, B0); PG8_MMA(1, 1, At, B1); PG8_BAR; PG8_SCHED;
        }
        if (wr == 0) PG8_BAR;
        E(acc, cur, wr, wc, fr, fq);
        if (!has_next) break;
        if (!KEEP_Z || nxt.z == 0) {
#pragma unroll
        for (int a = 0; a < 2; ++a)
#pragma unroll
            for (int b = 0; b < 2; ++b)
#pragma unroll
                for (int m = 0; m < 4; ++m)
#pragma unroll
                    for (int n = 0; n < 2; ++n) acc[a][b][m][n] = (f32x4){0.f, 0.f, 0.f, 0.f};
        }
        cur = nxt; cA = nA; cB = nB; ++ui;
        if (wr == 1) PG8_BAR;
    }
    PG8_WAIT_V(0);
    PG8_BAR;
#undef PG8_SA
#undef PG8_SB
#undef PG8_STAGE
#undef PG8_LDA
#undef PG8_LDB
#undef PG8_MMA
#undef PG8_WAIT_V
#undef PG8_WAIT_L
#undef PG8_BAR
#undef PG8_SCHED
}
}

struct Params {
    const float* in[23];
    float* out;
    unsigned char* ws;
};

__device__ __forceinline__ int map_in(int d) {
    if (d < 3200) return 6152 + d; if (d < 3208) return 5120 + (d - 3200); if (d < 3328) return -1; if (d < 4352) return 9352 + (d - 3328);
    if (d < 9472) return d - 4352; if (d < 10496) return 5128 + (d - 9472); return 10376 + (d - 10496); }
template <bool MAP>
__device__ __forceinline__ void transpose_item(const float* W, int K, int Nsrc, bf16_t* WT, LAS float* scr, int item, int nblk, int lane) {
    const int kb = item / nblk, nb = item - kb * nblk, k0 = 64 * kb, n0 = 32 * nb;
    if (MAP && n0 == COL_FL) {
        const int d = n0 + (lane & 31); const int sc = map_in(d);
#pragma unroll 8
        for (int i = 0; i < 32; ++i) { const int kk = 2 * i + (lane >> 5); scr[kk * 33 + (lane & 31)] = (sc >= 0) ? W[(size_t)(k0 + kk) * Nsrc + sc] : 0.f; }
    } else {
        const int sc0 = MAP ? map_in(n0) : n0;
        const int r8 = lane >> 3, c4 = lane & 7;
        f32x4 v[8];
#pragma unroll
        for (int i = 0; i < 8; ++i) v[i] = (sc0 >= 0) ? *(const f32x4*)(W + (size_t)(k0 + 8 * i + r8) * Nsrc + sc0 + 4 * c4) : (f32x4){0.f, 0.f, 0.f, 0.f};
#pragma unroll
        for (int i = 0; i < 8; ++i) { LAS float* d = scr + (8 * i + r8) * 33 + 4 * c4; d[0] = v[i][0]; d[1] = v[i][1]; d[2] = v[i][2]; d[3] = v[i][3]; }
    }
    LDS_WAIT(); asm volatile("" ::: "memory");
    const int c = lane & 7;
#pragma unroll
    for (int j = 0; j < 4; ++j) { const int n = (lane >> 3) + 8 * j; const LAS float* s = scr + (8 * c) * 33 + n;
        u32x4 o; o.x = pk2(s[0 * 33], s[1 * 33]); o.y = pk2(s[2 * 33], s[3 * 33]); o.z = pk2(s[4 * 33], s[5 * 33]); o.w = pk2(s[6 * 33], s[7 * 33]);
        *(u32x4*)(WT + (size_t)(n0 + n) * K + k0 + 8 * c) = o; }
    LDS_WAIT(); asm volatile("" ::: "memory");
}
__device__ __forceinline__ void convert_win(const float* w_in_l, bf16_t* WIN, LAS float* scr, int gw, int NGW, int lane) {
    constexpr int NBLK = NP / 32, NITEMS = (DM / 64) * NBLK;
    for (int it = gw; it < NITEMS; it += NGW) transpose_item<true>(w_in_l, DM, NIN, WIN, scr, it, NBLK, lane);
}
__device__ __forceinline__ void rms_row_store(const f32x4 (&v)[8], float ssum, const float* g, bf16_t* orow, int lane) {
    const float rs = 1.0f / sqrtf(ssum * (1.0f / DM) + NORM_EPS);
#pragma unroll
    for (int j = 0; j < 8; ++j) { const f32x4 gv = *((const f32x4*)g + lane + 64 * j);
        u32x2 w; w.x = pk2(v[j][0] * rs * gv[0], v[j][1] * rs * gv[1]); w.y = pk2(v[j][2] * rs * gv[2], v[j][3] * rs * gv[3]);
        *((u32x2*)orow + lane + 64 * j) = w; }
}

__device__ __forceinline__ void vt_unit(LAS unsigned char* lds, const bf16_t* P, bf16_t* Vt, const float* bfp, float* LSP, float* TS, unsigned* KN, int unit, int tid) {
    const int h = unit & 7, t0 = (unit >> 3) * 64;
    {
        const u32x4* kp = (const u32x4*)(P + (size_t)(t0 + (tid >> 3)) * NP + COL_K + h * 128 + (tid & 7) * 16);
        const u32x4 a = kp[0], b = kp[1]; float ss = 0.f;
        ss += bflo(a.x) * bflo(a.x) + bfhi(a.x) * bfhi(a.x) + bflo(a.y) * bflo(a.y) + bfhi(a.y) * bfhi(a.y) + bflo(a.z) * bflo(a.z) + bfhi(a.z) * bfhi(a.z) + bflo(a.w) * bflo(a.w) + bfhi(a.w) * bfhi(a.w);
        ss += bflo(b.x) * bflo(b.x) + bfhi(b.x) * bfhi(b.x) + bflo(b.y) * bflo(b.y) + bfhi(b.y) * bfhi(b.y) + bflo(b.z) * bflo(b.z) + bfhi(b.z) * bfhi(b.z) + bflo(b.w) * bflo(b.w) + bfhi(b.w) * bfhi(b.w);
        ss += dppf<0xB1>(ss); ss += dppf<0x4E>(ss); ss += dppf<0x141>(ss);
        ss = fmaxf(ss, __shfl_xor(ss, 8)); ss = fmaxf(ss, __shfl_xor(ss, 16)); ss = fmaxf(ss, __shfl_xor(ss, 32));
        if ((tid & 63) == 0) atomicMax(KN + h, __float_as_uint(ss));
    }
    if (tid < 64) {
        float x = logsigf_(bf2f(P[(size_t)(t0 + tid) * NP + COL_FL + h]) + bfp[h]);
#pragma unroll
        for (int o = 1; o < 64; o <<= 1) { const float y = __shfl_up(x, o); if (tid >= o) x += y; }
        LSP[(size_t)h * S_ + t0 + tid] = x; if (tid == 63) TS[h * 256 + (unit >> 3)] = x;
    }
    LAS unsigned short* T = (LAS unsigned short*)lds;
#pragma unroll
    for (int i = 0; i < 2; ++i) { const int id = tid + 512 * i, row = id >> 4, c16 = id & 15;
        const u32x4 v = *(const u32x4*)(P + (size_t)(t0 + row) * NP + COL_V + h * 128 + c16 * 8);
        LAS unsigned* dst = (LAS unsigned*)(T + row * 130 + c16 * 8); dst[0] = v.x; dst[1] = v.y; dst[2] = v.z; dst[3] = v.w; }
    __syncthreads();
#pragma unroll
    for (int i = 0; i < 2; ++i) { const int id = tid + 512 * i, d = id >> 3, t8 = id & 7;
        const LAS unsigned short* s = T + (t8 * 8) * 130 + d;
        u32x4 o; o.x = (unsigned)s[0] | ((unsigned)s[130] << 16); o.y = (unsigned)s[2 * 130] | ((unsigned)s[3 * 130] << 16);
        o.z = (unsigned)s[4 * 130] | ((unsigned)s[5 * 130] << 16); o.w = (unsigned)s[6 * 130] | ((unsigned)s[7 * 130] << 16);
        *(u32x4*)(Vt + (size_t)(h * 128 + d) * S_ + t0 + t8 * 8) = o; }
    __syncthreads();
}
struct RwkvW { const float *mu, *w0, *a0, *k_k, *k_a, *r_k; const bf16_t *wupt, *aupt; };
__device__ __forceinline__ void rwkv_prep_unit(LAS unsigned char* lds, const bf16_t* P, const RwkvW& W, float* decay, bf16_t* okk, bf16_t* ob, bf16_t* ok, bf16_t* orr, bf16_t* ov, float* bonus, int unit, int tid) {
    LAS unsigned short* X = (LAS unsigned short*)lds;
    LAS unsigned short* tw = X + 17 * 3200;
    LAS unsigned short* ca = tw + 16 * 72;
    const int t0 = unit * 16, wave = tid >> 6, lane = tid & 63, fr = lane & 15, fq = lane >> 4;
    {
        u32x4 v[14];
#pragma unroll
        for (int i = 0; i < 14; ++i) { const int id = tid + 512 * i; const int row = id / 400, ch = id - row * 400; const int t = t0 - 1 + row;
            v[i] = (u32x4){0u, 0u, 0u, 0u};
            if (id < 6800 && t >= 0) v[i] = *(const u32x4*)(P + (size_t)t * NP + COL_PC + ch * 8); }
#pragma unroll
        for (int i = 0; i < 14; ++i) { const int id = tid + 512 * i; const int row = id / 400, ch = id - row * 400;
            if (id < 6800) *(LAS u32x4*)(X + row * 3200 + ch * 8) = v[i]; }
    }
    __syncthreads();
#pragma unroll
    for (int i = 0; i < 4; ++i) { const int e = tid + 512 * i, tt = e >> 7, j = e & 127, col = 3072 + j;
        const float cur = bf2f(X[(tt + 1) * 3200 + col]), prev = bf2f(X[tt * 3200 + col]);
        const float xs = cur + (prev - cur) * W.mu[col];
        if (j < 64) tw[tt * 72 + j] = (unsigned short)f2bf(tanhf(xs)); else ca[tt * 72 + j - 64] = (unsigned short)f2bf(xs); }
    __syncthreads();
    bf16x8 Aw[2], Aa[2];
#pragma unroll
    for (int kk = 0; kk < 2; ++kk) { Aw[kk] = *(const LAS bf16x8*)(tw + fr * 72 + kk * 32 + fq * 8); Aa[kk] = *(const LAS bf16x8*)(ca + fr * 72 + kk * 32 + fq * 8); }
#pragma unroll 1
    for (int hi = 0; hi < 2; ++hi) {
        const int hh = wave + 8 * hi;
        float kkv[4][4], av[4][4], bop[4];
#pragma unroll
        for (int jj = 0; jj < 4; ++jj) bop[jj] = 0.f;
#pragma unroll
        for (int n = 0; n < 4; ++n) {
            const int c = hh * 64 + 16 * n + fr;
            f32x4 accw = {0.f, 0.f, 0.f, 0.f}, acca = {0.f, 0.f, 0.f, 0.f};
#pragma unroll
            for (int kk = 0; kk < 2; ++kk) { const bf16x8 Bw = *(const bf16x8*)(W.wupt + (size_t)c * 64 + kk * 32 + fq * 8), Ba = *(const bf16x8*)(W.aupt + (size_t)c * 64 + kk * 32 + fq * 8);
                accw = __builtin_amdgcn_mfma_f32_16x16x32_bf16(Aw[kk], Bw, accw, 0, 0, 0); acca = __builtin_amdgcn_mfma_f32_16x16x32_bf16(Aa[kk], Ba, acca, 0, 0, 0); }
            const float w0c = W.w0[c], a0c = W.a0[c], kkc = W.k_k[c], kac = W.k_a[c], rkc = W.r_k[c];
            const float mur = W.mu[c], muk = W.mu[1024 + c], muv = W.mu[2048 + c];
#pragma unroll
            for (int jj = 0; jj < 4; ++jj) {
                const int tt = 4 * fq + jj;
                const LAS unsigned short* x1 = X + (tt + 1) * 3200 + c; const LAS unsigned short* x0 = X + tt * 3200 + c;
                const float r1 = bf2f(x1[0]), k1 = bf2f(x1[1024]), v1 = bf2f(x1[2048]);
                const float cr = r1 + (bf2f(x0[0]) - r1) * mur, ck = k1 + (bf2f(x0[1024]) - k1) * muk, cv = v1 + (bf2f(x0[2048]) - v1) * muv;
                const float sig = 1.0f / (1.0f + __expf(-(w0c + accw[jj])));
                const float dec = __expf(-0.6065306597126334f * sig);
                const float a = 1.0f / (1.0f + __expf(-(a0c + acca[jj])));
                const float kp = ck * (1.0f + (a - 1.0f) * kac);
                kkv[n][jj] = ck * kkc; av[n][jj] = a; bop[jj] += cr * kp * rkc;
                const size_t o = (size_t)(t0 + tt) * DBR + c;
                decay[o] = dec; ok[o] = (bf16_t)f2bf(kp); orr[o] = (bf16_t)f2bf(cr); ov[o] = (bf16_t)f2bf(cv);
            }
        }
#pragma unroll
        for (int jj = 0; jj < 4; ++jj) {
            float ss = (kkv[0][jj] * kkv[0][jj] + kkv[1][jj] * kkv[1][jj]) + (kkv[2][jj] * kkv[2][jj] + kkv[3][jj] * kkv[3][jj]);
            ss = rowsum16(ss);
            const float rs = 1.0f / sqrtf(fmaxf(ss, 1e-24f));
            const float bo = rowsum16(bop[jj]);
            const int t = t0 + 4 * fq + jj;
#pragma unroll
            for (int n = 0; n < 4; ++n) { const size_t o = (size_t)t * DBR + hh * 64 + 16 * n + fr; const float kkn = kkv[n][jj] * rs;
                okk[o] = (bf16_t)f2bf(kkn); ob[o] = (bf16_t)f2bf(kkn * av[n][jj]); }
            if (fr == 0) bonus[(size_t)t * 16 + hh] = bo;
        }
    }
    __syncthreads();
}

struct RwStep { f32x4 w, kk, bb, kv, rr; };
__device__ __forceinline__ void rwkv_seq(LAS unsigned char* lds, const float* decay, const bf16_t* akk, const bf16_t* ab, const bf16_t* ak, const bf16_t* ar, const bf16_t* av, float* Yraw, int blk, int tid) {
    const int hh = blk >> 2, qv = blk & 3;
    const int wave = tid >> 6, lane = tid & 63;
    LAS float* tile = (LAS float*)lds;
    LAS float* vbuf = (LAS float*)(lds + 81920);
    LAS float* ypart = (LAS float*)(lds + 81920 + 4096);
    const bool loader = wave >= 4;
    const int lt = tid & 255;
    constexpr int NT = S_ / 32;
    f32x4 rw[2]; u32x2 rk[4][2]; unsigned rv[2];
    const size_t cbase = (size_t)hh * 64;
#define RW_ISSUE(n) do { _Pragma("unroll") for (int i_ = 0; i_ < 2; ++i_) { const int e_ = lt + 256 * i_, st_ = e_ >> 4, c4_ = e_ & 15; \
        const size_t gi_ = (size_t)((n) * 32 + st_) * DBR + cbase + c4_ * 4; \
        rw[i_] = *(const f32x4*)(decay + gi_); rk[0][i_] = *(const u32x2*)(akk + gi_); rk[1][i_] = *(const u32x2*)(ab + gi_); rk[2][i_] = *(const u32x2*)(ak + gi_); rk[3][i_] = *(const u32x2*)(ar + gi_); \
        rv[i_] = av[(size_t)((n) * 32 + st_) * DBR + cbase + qv * 16 + c4_]; } } while (0)
#define RW_WRITE(b) do { _Pragma("unroll") for (int i_ = 0; i_ < 2; ++i_) { const int e_ = lt + 256 * i_, st_ = e_ >> 4, c4_ = e_ & 15; \
        LAS float* d_ = tile + ((b) * 32 + st_) * 320 + c4_ * 4; *(LAS f32x4*)d_ = rw[i_]; \
        _Pragma("unroll") for (int a_ = 0; a_ < 4; ++a_) { f32x4 f_; f_[0] = bflo(rk[a_][i_].x); f_[1] = bfhi(rk[a_][i_].x); f_[2] = bflo(rk[a_][i_].y); f_[3] = bfhi(rk[a_][i_].y); *(LAS f32x4*)(d_ + 64 * (a_ + 1)) = f_; } \
        vbuf[((b) * 16 + c4_) * 32 + st_] = bf2f(rv[i_]); } } while (0)
#define RW_FLUSH(n, b) do { _Pragma("unroll") for (int i_ = 0; i_ < 2; ++i_) { const int e_ = lt + 256 * i_, st_ = e_ >> 4, r_ = e_ & 15; \
        const LAS f32x4* yp_ = (const LAS f32x4*)(ypart + (((b) * 32 + st_) * 16 + r_) * 8); const f32x4 a_ = yp_[0], c_ = yp_[1]; \
        Yraw[(size_t)((n) * 32 + st_) * DBR + cbase + qv * 16 + r_] = ((a_[0] + a_[1]) + (a_[2] + a_[3])) + ((c_[0] + c_[1]) + (c_[2] + c_[3])); } } while (0)
    if (loader) { RW_ISSUE(0); RW_WRITE(0); }
    __syncthreads();
    const int row_l = (wave & 3) * 4 + (lane >> 4), ks = lane & 15;
    f32x2 s01 = {0.f, 0.f}, s23 = {0.f, 0.f};
#define RW_LD(dst, st_) do { const LAS float* bs_ = tb + (st_) * 320; dst.w = *(const LAS f32x4*)bs_; dst.kk = *(const LAS f32x4*)(bs_ + 64); dst.bb = *(const LAS f32x4*)(bs_ + 128); \
        dst.kv = *(const LAS f32x4*)(bs_ + 192); dst.rr = *(const LAS f32x4*)(bs_ + 256); } while (0)
#define RW_STEP(src, st_) do { const f32x2 t_ = s01 * (f32x2){src.kk[0], src.kk[1]} + s23 * (f32x2){src.kk[2], src.kk[3]}; \
        const float sa_ = -rowsum16(t_[0] + t_[1]); const float vr_ = vq[(st_) >> 2][(st_) & 3]; \
        s01 = s01 * (f32x2){src.w[0], src.w[1]} + sa_ * (f32x2){src.bb[0], src.bb[1]} + vr_ * (f32x2){src.kv[0], src.kv[1]}; \
        s23 = s23 * (f32x2){src.w[2], src.w[3]} + sa_ * (f32x2){src.bb[2], src.bb[3]} + vr_ * (f32x2){src.kv[2], src.kv[3]}; \
        const f32x2 yv_ = s01 * (f32x2){src.rr[0], src.rr[1]} + s23 * (f32x2){src.rr[2], src.rr[3]}; \
        float y_ = yv_[0] + yv_[1]; y_ += dppf<0xB1>(y_); \
        yb[(st_) * 128] = y_; } while (0)
    for (int n = 0; n < NT; ++n) {
        const int b = n & 1;
        if (loader) {
            if (n + 1 < NT) RW_ISSUE(n + 1);
            if (n > 0) RW_FLUSH(n - 1, b ^ 1);
            if (n + 1 < NT) RW_WRITE(b ^ 1);
        } else {
            RwStep ca, cb;
            const LAS float* tb = tile + b * (32 * 320) + 4 * ks;
            LAS float* yb = ypart + (b * 512 + row_l) * 8 + (ks >> 1);
            f32x4 vq[8];
            RW_LD(ca, 0);
            __builtin_amdgcn_sched_barrier(0);
            { const LAS f32x4* vb = (const LAS f32x4*)(vbuf + (b * 16 + row_l) * 32);
#pragma unroll
              for (int q = 0; q < 8; ++q) vq[q] = vb[q]; }
            __builtin_amdgcn_sched_barrier(0);
#pragma unroll
            for (int st = 0; st < 32; st += 2) {
                RW_LD(cb, st + 1);
                RW_STEP(ca, st);
                if (st + 2 < 32) RW_LD(ca, st + 2);
                RW_STEP(cb, st + 1);
            }
        }
        __syncthreads();
    }
    if (loader) RW_FLUSH(NT - 1, (NT - 1) & 1);
    __syncthreads();
#undef RW_ISSUE
#undef RW_WRITE
#undef RW_FLUSH
#undef RW_LD
#undef RW_STEP
}

struct LruW { const float *conv_w, *conv_b, *gate_b, *lam; const bf16_t* wgt; };
__device__ __forceinline__ void lru_chunk_unit(LAS unsigned char* lds, const bf16_t* P, const LruW& W, bf16_t* HL, bf16_t* ACUM, float* AGA, float* AGB, int unit, int tid) {
    const int h = unit & 15, ci = unit >> 4, t0 = ci * 64;
    const int wave = tid >> 6, lane = tid & 63;
    LAS float* xcf = (LAS float*)lds;
    LAS float* As = xcf + 4096;
    LAS float* Bs = As + 4096;
    LAS float* SA = Bs + 4096;
    LAS float* SB = SA + 512;
    LAS unsigned short* xcb = (LAS unsigned short*)(SB + 512 + 64);
    const int c = tid & 63, tg = tid >> 6;
    const int ch = h * 64 + c;
    const float cw0 = W.conv_w[0 * DBR + ch], cw1 = W.conv_w[1 * DBR + ch], cw2 = W.conv_w[2 * DBR + ch], cw3 = W.conv_w[3 * DBR + ch], cb = W.conv_b[ch];
    float xa[11];
#pragma unroll
    for (int i = 0; i < 11; ++i) { const int t = t0 + tg * 8 + i - 3; xa[i] = (t >= 0) ? bf2f(P[(size_t)t * NP + COL_XA + ch]) : 0.f; }
    const int tb = wave & 3, chh = wave >> 2, fr = lane & 15, fq = lane >> 4;
    bf16x8 Bf[2][2][2];
    float gb0[2], gb1[2], sp[2];
#pragma unroll
    for (int n = 0; n < 2; ++n) { const int j = 32 * chh + 16 * n + fr;
        gb0[n] = W.gate_b[h * 64 + j]; gb1[n] = W.gate_b[DBR + h * 64 + j]; sp[n] = softplusf_(-W.lam[h * 64 + j]);
#pragma unroll
        for (int g = 0; g < 2; ++g)
#pragma unroll
            for (int kk = 0; kk < 2; ++kk) Bf[g][n][kk] = *(const bf16x8*)(W.wgt + ((size_t)((g * 16 + h) * 64 + j)) * 64 + kk * 32 + fq * 8); }
#pragma unroll
    for (int tt = 0; tt < 8; ++tt) {
        const float xc = cb + cw0 * xa[tt] + cw1 * xa[tt + 1] + cw2 * xa[tt + 2] + cw3 * xa[tt + 3];
        xcf[(tg * 8 + tt) * 64 + c] = xc; xcb[(tg * 8 + tt) * 72 + c] = (unsigned short)f2bf(xc);
    }
    __syncthreads();
    {
        bf16x8 Af[2];
#pragma unroll
        for (int kk = 0; kk < 2; ++kk) Af[kk] = *(const LAS bf16x8*)(xcb + (tb * 16 + fr) * 72 + kk * 32 + fq * 8);
        f32x4 acc[2][2];
#pragma unroll
        for (int g = 0; g < 2; ++g)
#pragma unroll
            for (int n = 0; n < 2; ++n) { acc[g][n] = (f32x4){0.f, 0.f, 0.f, 0.f};
#pragma unroll
                for (int kk = 0; kk < 2; ++kk) acc[g][n] = __builtin_amdgcn_mfma_f32_16x16x32_bf16(Af[kk], Bf[g][n][kk], acc[g][n], 0, 0, 0); }
#pragma unroll
        for (int n = 0; n < 2; ++n)
#pragma unroll
            for (int jj = 0; jj < 4; ++jj) {
                const int tl = tb * 16 + 4 * fq + jj, cc = 32 * chh + 16 * n + fr;
                const float r = 1.0f / (1.0f + __expf(-(acc[0][n][jj] + gb0[n])));
                const float ig = 1.0f / (1.0f + __expf(-(acc[1][n][jj] + gb1[n])));
                const float la = -8.0f * r * sp[n];
                const float a = expf(la);
                float mult = sqrtf(-expm1f(2.0f * la));
                if (t0 + tl == 0) mult = 1.0f;
                As[tl * 64 + cc] = a; Bs[tl * 64 + cc] = mult * ig * xcf[tl * 64 + cc];
            }
    }
    __syncthreads();
    float hl[8], ac[8];
    {
        float hrun = 0.f, arun = 1.f;
#pragma unroll
        for (int tt = 0; tt < 8; ++tt) { const float a = As[(tg * 8 + tt) * 64 + c], b = Bs[(tg * 8 + tt) * 64 + c]; hrun = a * hrun + b; arun *= a; hl[tt] = hrun; ac[tt] = arun; }
        SA[tg * 64 + c] = arun; SB[tg * 64 + c] = hrun;
    }
    __syncthreads();
    float hin = 0.f, cin = 1.f;
    for (int s = 0; s < tg; ++s) { const float sa = SA[s * 64 + c]; hin = sa * hin + SB[s * 64 + c]; cin *= sa; }
#pragma unroll
    for (int tt = 0; tt < 8; ++tt) { const float hv = hl[tt] + ac[tt] * hin, av = ac[tt] * cin; const size_t o = (size_t)(t0 + tg * 8 + tt) * DBR + ch;
        HL[o] = (bf16_t)f2bf(hv); ACUM[o] = (bf16_t)f2bf(av);
        if (tt == 7 && tg == 7) { AGA[(size_t)ci * DBR + ch] = av; AGB[(size_t)ci * DBR + ch] = hv; } }
    __syncthreads();
}

constexpr int AT_KROW = 136 * 2;
constexpr int AT_VROW = 68 * 2;
constexpr int AT_KBYTES = 64 * AT_KROW;
constexpr int AT_VBYTES = 128 * AT_VROW;
constexpr int AT_BUF = AT_KBYTES + AT_VBYTES + 256;
__device__ __forceinline__ void attn_unit(LAS unsigned char* lds, const bf16_t* P, const bf16_t* Vt, const float* C, const float* TS, const unsigned* KN, bf16_t* Yb, int h, int qb, int tid) {
    const int wave = tid >> 6, lane = tid & 63, ql = lane & 31, hf = lane >> 5;
    LAS float* offs = (LAS float*)(lds + 2 * AT_BUF);
    LAS float* needw = offs + 256;
    if (tid < 64) { const f32x4 v = *(const f32x4*)(TS + h * 256 + 4 * tid); float x = (v[0] + v[1]) + (v[2] + v[3]);
#pragma unroll
        for (int o = 1; o < 64; o <<= 1) { const float y = __shfl_up(x, o); if (tid >= o) x += y; }
        const float e0 = x - ((v[0] + v[1]) + (v[2] + v[3]));
        *(LAS f32x4*)(offs + 4 * tid) = (f32x4){e0, e0 + v[0], e0 + v[0] + v[1], e0 + v[0] + v[1] + v[2]}; }
    __syncthreads();
    const int qw0 = qb * 256 + wave * 32, q = qw0 + ql;
    bf16x8 Qf[8];
    { const bf16_t* qp = P + (size_t)q * NP + COL_Q + h * 128 + 8 * hf;
#pragma unroll
      for (int ks = 0; ks < 8; ++ks) Qf[ks] = *(const bf16x8*)(qp + 16 * ks); }
    const float cq = (offs[q >> 6] + C[(size_t)h * S_ + q]) * LOG2E;
    const float SC = 0.08838834764831845f * LOG2E;
    float qss = 0.f;
#pragma unroll
    for (int ks = 0; ks < 8; ++ks)
#pragma unroll
        for (int e = 0; e < 8; ++e) { const float v = bf2f((unsigned)(unsigned short)Qf[ks][e]); qss += v * v; }
    qss += __shfl_xor(qss, 32);
    const float needc = sqrtf(qss) * sqrtf(__uint_as_float(KN[h])) * SC * 1.001f + cq + 40.0f;
    f32x16 O[4];
#pragma unroll
    for (int db = 0; db < 4; ++db)
#pragma unroll
        for (int i = 0; i < 16; ++i) O[db][i] = 0.f;
    float m = -INFINITY, l = 0.f;
    const int ntile = 4 * qb + 4;
    u32x4 kreg[2], vreg[2]; float ckreg = 0.f;
    const bf16_t* kbase = P + COL_K + h * 128;
    const bf16_t* vbase = Vt + (size_t)h * 128 * S_;
    const float* cbase = C + (size_t)h * S_;
#define AT_LOAD(kt_) do { const int k0_ = (kt_) * 64; _Pragma("unroll") for (int i_ = 0; i_ < 2; ++i_) { const int id_ = tid + 512 * i_; \
        kreg[i_] = *(const u32x4*)(kbase + (size_t)(k0_ + (id_ >> 4)) * NP + (id_ & 15) * 8); \
        vreg[i_] = *(const u32x4*)(vbase + (size_t)(id_ >> 3) * S_ + k0_ + (id_ & 7) * 8); } \
        if (tid < 64) ckreg = (offs[(kt_)] + cbase[k0_ + tid]) * LOG2E; } while (0)
#define AT_WRITE(b_) do { LAS unsigned char* bb_ = lds + (b_) * AT_BUF; _Pragma("unroll") for (int i_ = 0; i_ < 2; ++i_) { const int id_ = tid + 512 * i_; \
        *(LAS u32x4*)(bb_ + (id_ >> 4) * AT_KROW + (id_ & 15) * 16) = kreg[i_]; \
        LAS u32x2* vd_ = (LAS u32x2*)(bb_ + AT_KBYTES + (id_ >> 3) * AT_VROW + (id_ & 7) * 16); vd_[0] = (u32x2){vreg[i_].x, vreg[i_].y}; vd_[1] = (u32x2){vreg[i_].z, vreg[i_].w}; } \
        if (tid < 64) *(LAS float*)(bb_ + AT_KBYTES + AT_VBYTES + tid * 4) = ckreg; } while (0)
    AT_LOAD(ntile - 1); AT_WRITE(0);
    if (tid < 16) needw[tid] = INFINITY;
    __syncthreads();
    for (int it = 0; it < ntile; ++it) {
        const int kt = ntile - 1 - it, b = it & 1;
        bool more = (kt > 0);
        if (more) {
            const LAS float* nw = needw + ((it & 1) ^ 1) * 8;
            const f32x4 n0 = *(const LAS f32x4*)nw, n1 = *(const LAS f32x4*)(nw + 4);
            const float need = fmaxf(fmaxf(fmaxf(n0[0], n0[1]), fmaxf(n0[2], n0[3])), fmaxf(fmaxf(n1[0], n1[1]), fmaxf(n1[2], n1[3])));
            more = !(need <= offs[kt] * LOG2E);
        }
        if (more) AT_LOAD(kt - 1);
        const int k0 = kt * 64;
        float nd = INFINITY;
        if (k0 <= qw0 + 31) {
            const LAS unsigned char* Kl = lds + b * AT_BUF;
            const LAS unsigned char* Vl = Kl + AT_KBYTES;
            const LAS float* ckl = (const LAS float*)(Vl + AT_VBYTES);
            f32x16 Sx[2];
#pragma unroll
            for (int kb = 0; kb < 2; ++kb) {
#pragma unroll
                for (int i = 0; i < 16; ++i) Sx[kb][i] = 0.f;
#pragma unroll
                for (int ks = 0; ks < 8; ++ks) { const bf16x8 A = *(const LAS bf16x8*)(Kl + (kb * 32 + ql) * AT_KROW + (16 * ks + 8 * hf) * 2);
                    Sx[kb] = __builtin_amdgcn_mfma_f32_32x32x16_bf16(A, Qf[ks], Sx[kb], 0, 0, 0); }
            }
            const bool diag = (k0 + 63 > qw0);
            float mx = m;
#pragma unroll
            for (int kb = 0; kb < 2; ++kb)
#pragma unroll
                for (int i4 = 0; i4 < 4; ++i4) { const f32x4 ckv = *(const LAS f32x4*)(ckl + 32 * kb + 8 * i4 + 4 * hf);
#pragma unroll
                    for (int j = 0; j < 4; ++j) { const int i = 4 * i4 + j; float s = Sx[kb][i] * SC + (cq - ckv[j]);
                        if (diag) { const int key = k0 + 32 * kb + 8 * i4 + 4 * hf + j; if (key > q) s = -INFINITY; }
                        Sx[kb][i] = s; mx = fmaxf(mx, s); } }
            mx = fmaxf(mx, __shfl_xor(mx, 32));
            const float alpha = __builtin_amdgcn_exp2f(m - mx);
            m = mx; l *= alpha;
#pragma unroll
            for (int kb = 0; kb < 2; ++kb)
#pragma unroll
                for (int i = 0; i < 16; ++i) { const float p = __builtin_amdgcn_exp2f(Sx[kb][i] - mx); Sx[kb][i] = p; l += p; }
#pragma unroll
            for (int db = 0; db < 4; ++db)
#pragma unroll
                for (int i = 0; i < 16; ++i) O[db][i] *= alpha;
            bf16x8 Pf[4];
#pragma unroll
            for (int s = 0; s < 4; ++s) { const int kb = s >> 1, i0 = 8 * (s & 1);
                u32x4 w; w.x = cvt_pk_bf16(Sx[kb][i0 + 0], Sx[kb][i0 + 1]); w.y = cvt_pk_bf16(Sx[kb][i0 + 2], Sx[kb][i0 + 3]); w.z = cvt_pk_bf16(Sx[kb][i0 + 4], Sx[kb][i0 + 5]); w.w = cvt_pk_bf16(Sx[kb][i0 + 6], Sx[kb][i0 + 7]);
                Pf[s] = __builtin_bit_cast(bf16x8, w); }
#pragma unroll
            for (int db = 0; db < 4; ++db)
#pragma unroll
                for (int s = 0; s < 4; ++s) { const LAS unsigned char* vp = Vl + (32 * db + ql) * AT_VROW + (16 * s + 4 * hf) * 2;
                    const u32x2 lo = *(const LAS u32x2*)vp, hi = *(const LAS u32x2*)(vp + 16);
                    const u32x4 a4 = {lo.x, lo.y, hi.x, hi.y};
                    O[db] = __builtin_amdgcn_mfma_f32_32x32x16_bf16(__builtin_bit_cast(bf16x8, a4), Pf[s], O[db], 0, 0, 0); }
            nd = needc - m;
            nd = fmaxf(nd, dppf<0xB1>(nd)); nd = fmaxf(nd, dppf<0x4E>(nd)); nd = fmaxf(nd, dppf<0x141>(nd)); nd = fmaxf(nd, dppf<0x140>(nd));
            nd = fmaxf(nd, __shfl_xor(nd, 16)); nd = fmaxf(nd, __shfl_xor(nd, 32));
        }
        if (lane == 0) needw[(it & 1) * 8 + wave] = nd;
        if (more) AT_WRITE(b ^ 1);
        __syncthreads();
        if (!more) break;
    }
    l += __shfl_xor(l, 32);
    const float inv = 1.0f / l;
#pragma unroll
    for (int db = 0; db < 4; ++db)
#pragma unroll
        for (int i4 = 0; i4 < 4; ++i4) { const int d = 32 * db + 8 * i4 + 4 * hf;
            const u32x2 g = *(const u32x2*)(P + (size_t)q * NP + COL_GB + h * 128 + d);
            const float o0 = O[db][4 * i4 + 0] * inv * siluf_(bflo(g.x)), o1 = O[db][4 * i4 + 1] * inv * siluf_(bfhi(g.x));
            const float o2 = O[db][4 * i4 + 2] * inv * siluf_(bflo(g.y)), o3 = O[db][4 * i4 + 3] * inv * siluf_(bfhi(g.y));
            u32x2 w; w.x = cvt_pk_bf16(o0, o1); w.y = cvt_pk_bf16(o2, o3);
            *(u32x2*)(Yb + (size_t)q * DBR + h * 128 + d) = w; }
#undef AT_LOAD
#undef AT_WRITE
}

#ifndef P4S
#define P4SEL(n) 1
#else
#define P4SEL(n) (P4S == (n))
#endif
#ifndef PH
#define PHSEL(n) 1
#else
#define PHSEL(n) ((PH) >= 100 ? ((n) != (PH) - 100) : (PH) == (n))
#endif
#ifndef REPRW
#define REPRW 1
#endif
#ifndef REP2
#define REP2 1
#endif
#ifndef REP3
#define REP3 1
#endif
#ifndef REP4
#define REP4 1
#endif
#ifndef REP5
#define REP5 1
#endif
typedef __attribute__((address_space(4))) const Params* KP;
#define KP_FRESH(kp) KP kp = (KP)__builtin_amdgcn_kernarg_segment_ptr(); asm volatile("" : "+s"(kp))

__global__ void __launch_bounds__(512) hybrid_fwd(Params p_unused) {
    extern __shared__ __attribute__((aligned(16))) unsigned char lds_raw[];
    LAS unsigned char* lds = (LAS unsigned char*)lds_raw;
    cg::grid_group grid = cg::this_grid();
    const int G = gridDim.x, bid = blockIdx.x, NGW = G * 8;
    if (threadIdx.x < 2) ((volatile LAS unsigned*)(lds + XB_ST_OFF))[threadIdx.x] = 0u;
    { KP_FRESH(kpb); unsigned* ctl0 = (unsigned*)(kpb->ws + OFF_CTL);
      for (int w = bid * 512 + (int)threadIdx.x; w < CW_XBAR + XCD_BAR_WORDS; w += G * 512) ctl0[w] = 0u; }
    __syncthreads();
#define GRID_BAR() do { KP_FRESH(kpb_); XcdBarrier b_; b_.bar = (unsigned*)(kpb_->ws + OFF_CTL) + CW_XBAR; b_.x = xb_xcc_id(); b_.st = (volatile LAS unsigned*)(lds + XB_ST_OFF); xcd_barrier(b_); } while (0)
#define TID_FRESH() const int tid = fresh_tid(), lane = tid & 63, wave = __builtin_amdgcn_readfirstlane(tid >> 6), gw = bid * 8 + wave; (void)lane; (void)gw

#if PHSEL(0)
    {
        KP_FRESH(kp); TID_FRESH();
        unsigned char* ws = kp->ws;
        LAS float* scr = (LAS float*)(lds + wave * 16384);
        convert_win(kp->in[3], (bf16_t*)(ws + OFF_WIN), scr, gw, NGW, lane);
#pragma unroll 1
        for (int l = 0; l < 2; ++l) {
            bf16_t* WBR = (bf16_t*)(ws + OFF_WSM + l * SZ_WSM_L); bf16_t* WOUT = (bf16_t*)((unsigned char*)WBR + SZ_WBR); bf16_t* WGT = (bf16_t*)((unsigned char*)WOUT + SZ_WOUT);
#pragma unroll 1
            for (int z = 0; z < 3; ++z) { const float* src = kp->in[21] + (size_t)(l * 3 + z) * DBR * DM;
                for (int it = gw; it < (DBR / 64) * (DM / 32); it += NGW) transpose_item<false>(src, DBR, DM, WBR + (size_t)z * DM * DBR, scr, it, DM / 32, lane); }
            { const float* src = kp->in[22] + (size_t)l * DM * DM;
                for (int it = gw; it < (DM / 64) * (DM / 32); it += NGW) transpose_item<false>(src, DM, DM, WOUT, scr, it, DM / 32, lane); }
            { bf16_t* WL = (bf16_t*)((unsigned char*)WGT + SZ_WGT); const float* wu = kp->in[13] + (size_t)l * 64 * DBR; const float* au = kp->in[15] + (size_t)l * 64 * DBR;
                for (int e = bid * 512 + tid; e < DBR * 64; e += G * 512) { const int k = e & 63, c = e >> 6; WL[e] = (bf16_t)f2bf(wu[(size_t)k * DBR + c]); WL[(size_t)DBR * 64 + e] = (bf16_t)f2bf(au[(size_t)k * DBR + c]); } }
            { const float* src = kp->in[7] + (size_t)l * 2 * 16 * 64 * 64;
                for (int e = bid * 512 + tid; e < 2 * 16 * 64 * 64; e += G * 512) { const int i = e & 63, j = (e >> 6) & 63, gh = e >> 12; WGT[e] = (bf16_t)f2bf(src[(size_t)gh * 4096 + i * 64 + j]); } }
        }
        const float* x = kp->in[0]; const float* pre = kp->in[1]; bf16_t* H = (bf16_t*)(ws + OFF_HY);
#pragma unroll 2
        for (int row = gw; row < S_; row += NGW) {
            const f32x4* xr = (const f32x4*)(x + (size_t)row * DM) + lane; f32x4 v[8]; float s = 0.f;
#pragma unroll
            for (int j = 0; j < 8; ++j) { v[j] = xr[64 * j]; s += (v[j][0] * v[j][0] + v[j][1] * v[j][1]) + (v[j][2] * v[j][2] + v[j][3] * v[j][3]); }
            rms_row_store(v, wave_sum(s), pre, H + (size_t)row * DM, lane);
        }
    }
#endif
    grid.sync();
    { KP_FRESH(kpb); if (threadIdx.x == 0) (void)xb_add((unsigned*)(kpb->ws + OFF_CTL) + CW_XBAR + XB_XCNT(xb_xcc_id()), 1u); }

#pragma unroll 1
    for (int l = 0; l < 2; ++l) {
        { KP_FRESH(kp); TID_FRESH(); unsigned char* ws = kp->ws;
          pg8::Gemm g{(const bf16_t*)(ws + OFF_HY), (const bf16_t*)(ws + OFF_WIN), S_, NA, DM, 0, 0}; pg8::StaticOrder so; so.init(S_, NA, G, bid, 1);
          pg8::EpiStore E{(bf16_t*)(ws + OFF_P), NP};
          pg8::gemm_phase<pg8::EpiStore>(lds, g, so, E); }
        {
            const int nfill_blk = G - ((S_ / 256) * (NA / 256)) % G;
            const int first = G - nfill_blk;
            KP_FRESH(kp); TID_FRESH(); unsigned char* ws = kp->ws;
            if (bid >= first) {
                pg8::Gemm g{(const bf16_t*)(ws + OFF_HY), (const bf16_t*)(ws + OFF_WIN) + (size_t)(NP - NFILL) * DM, S_, NFILL, DM, 0, 0}; pg8::StaticOrder so; so.init(S_, NFILL, nfill_blk, bid - first, 1);
                pg8::EpiStoreGate E{(bf16_t*)(ws + OFF_P) + (NP - NFILL), NP, 0, kp->in[4] + (size_t)l * 3 * DM + (NP - NFILL - COL_MG)};
                pg8::gemm_phase<pg8::EpiStoreGate>(lds, g, so, E);
            }
        }
        GRID_BAR();
        {
            KP_FRESH(kp); TID_FRESH(); unsigned char* ws = kp->ws;
            const bf16_t* P = (const bf16_t*)(ws + OFF_P);
            const bf16_t* wlora = (const bf16_t*)(ws + OFF_WSM + l * SZ_WSM_L + SZ_WBR + SZ_WOUT + SZ_WGT);
            RwkvW rw{kp->in[11] + (size_t)l * 3200, kp->in[12] + (size_t)l * DBR, kp->in[14] + (size_t)l * DBR, kp->in[16] + (size_t)l * DBR, kp->in[17] + (size_t)l * DBR, kp->in[18] + (size_t)l * DBR, wlora, wlora + (size_t)DBR * 64};
            float* DEC = (float*)(ws + OFF_RW); bf16_t* RKK = (bf16_t*)(ws + OFF_RW + SZ_DEC);
            for (int u = bid; u < S_ / 16; u += G)
                rwkv_prep_unit(lds, P, rw, DEC, RKK, RKK + (size_t)S_ * DBR, RKK + (size_t)2 * S_ * DBR, RKK + (size_t)3 * S_ * DBR, RKK + (size_t)4 * S_ * DBR, (float*)(ws + OFF_BON), u, tid);
        }
        GRID_BAR();
        {
            const unsigned GB = (unsigned)(G - N_RWKV_BLK);
            if (bid < N_RWKV_BLK) {
                { KP_FRESH(kp); TID_FRESH(); unsigned char* ws = kp->ws;
                  const bf16_t* RKK = (const bf16_t*)(ws + OFF_RW + SZ_DEC);
                  for (int rr_ = 0; rr_ < REPRW; ++rr_) rwkv_seq(lds, (const float*)(ws + OFF_RW), RKK, RKK + (size_t)S_ * DBR, RKK + (size_t)2 * S_ * DBR, RKK + (size_t)3 * S_ * DBR, RKK + (size_t)4 * S_ * DBR, (float*)(ws + OFF_YRAW), bid, tid); }
                { KP_FRESH(kp); part_wait((unsigned*)(kp->ws + OFF_CTL) + CW_PB + 64 * l, 2 * GB); }
            } else {
                { KP_FRESH(kp); TID_FRESH(); unsigned char* ws = kp->ws;
                  pg8::Gemm g{(const bf16_t*)(ws + OFF_HY), (const bf16_t*)(ws + OFF_WIN) + (size_t)NA * DM, S_, NP - NA - NFILL, DM, 0, 0}; pg8::StaticOrder so; so.init(S_, NP - NA - NFILL, (int)GB, bid - N_RWKV_BLK, 1);
                  pg8::EpiStoreGate E{(bf16_t*)(ws + OFF_P) + NA, NP, (COL_MG - NA) / 256, kp->in[4] + (size_t)l * 3 * DM};
                  pg8::gemm_phase<pg8::EpiStoreGate>(lds, g, so, E); }
                { KP_FRESH(kp); part_barrier((unsigned*)(kp->ws + OFF_CTL) + CW_PB + 64 * l, GB); }
                { KP_FRESH(kp); TID_FRESH(); unsigned char* ws = kp->ws;
                  const bf16_t* P = (const bf16_t*)(ws + OFF_P);
                  constexpr int NU_VT = (S_ / 64) * 8, NU_LRU = 16 * (S_ / 64);
                  LruW lw{kp->in[5] + (size_t)l * 4 * DBR, kp->in[6] + (size_t)l * DBR, kp->in[8] + (size_t)l * 2 * DBR, kp->in[9] + (size_t)l * DBR, (const bf16_t*)(ws + OFF_WSM + l * SZ_WSM_L + SZ_WBR + SZ_WOUT)};
                  for (int u = bid - N_RWKV_BLK; u < NU_VT + NU_LRU; u += (int)GB) {
                      if (u >= NU_VT) lru_chunk_unit(lds, P, lw, (bf16_t*)(ws + OFF_HY), (bf16_t*)(ws + OFF_ACUM), (float*)(ws + OFF_AGA), (float*)(ws + OFF_AGB), u - NU_VT, tid);
                      else vt_unit(lds, P, (bf16_t*)(ws + OFF_VT), kp->in[10] + l * 8, (float*)(ws + OFF_C), (float*)(ws + OFF_TS), (unsigned*)(ws + OFF_CTL) + CW_KN + 64 * l, u, tid);
                  } }
                { KP_FRESH(kp); part_barrier((unsigned*)(kp->ws + OFF_CTL) + CW_PB + 64 * l, 2 * GB); }
                if (bid == N_RWKV_BLK) { KP_FRESH(kp); TID_FRESH(); unsigned char* ws = kp->ws;
                    const float* AGA = (const float*)(ws + OFF_AGA); const float* AGB = (const float*)(ws + OFF_AGB); float* CIN = (float*)(ws + OFF_CIN);
#pragma unroll
                    for (int cc = 0; cc < 2; ++cc) { const int c = tid + 512 * cc; float carry = 0.f;
#pragma unroll 8
                        for (int ci = 0; ci < S_ / 64; ++ci) { CIN[(size_t)ci * DBR + c] = carry; carry = AGA[(size_t)ci * DBR + c] * carry + AGB[(size_t)ci * DBR + c]; } }
                }
            }
            { KP_FRESH(kp); TID_FRESH(); unsigned char* ws = kp->ws;
            LAS int* sh = (LAS int*)(lds + 144 * 1024 - 64);
            unsigned* ctr = (unsigned*)(ws + OFF_CTL) + CW_ATTN + 64 * l;
            for (;;) {
                __syncthreads();
                if (tid == 0) *sh = (int)atomicAdd(ctr, 1u);
                __syncthreads();
                const int u = *sh;
                if (u >= 512) break;
                attn_unit(lds, (const bf16_t*)(ws + OFF_P), (const bf16_t*)(ws + OFF_VT), (const float*)(ws + OFF_C), (const float*)(ws + OFF_TS), (const unsigned*)(ws + OFF_CTL) + CW_KN + 64 * l, (bf16_t*)(ws + OFF_HY) + (size_t)S_ * DBR, u & 7, 63 - (u >> 3), tid);
            } }
        }
        GRID_BAR();
#if PHSEL(5)
        {
            KP_FRESH(kp); TID_FRESH(); unsigned char* ws = kp->ws;
            bf16_t* Yc = (bf16_t*)(ws + OFF_HY) + (size_t)2 * S_ * DBR; bf16_t* Ya = (bf16_t*)(ws + OFF_HY);
            const bf16_t* ACUM = (const bf16_t*)(ws + OFF_ACUM); const float* CIN = (const float*)(ws + OFF_CIN);
            const float* YRAW = (const float*)(ws + OFF_YRAW); const float* BON = (const float*)(ws + OFF_BON);
            const bf16_t* RV = (const bf16_t*)(ws + OFF_RW + SZ_DEC) + (size_t)4 * S_ * DBR; const bf16_t* P = (const bf16_t*)(ws + OFF_P);
            const int q4 = (tid & 255) * 4, hh = q4 >> 6;
            const f32x4 lnw = *(const f32x4*)(kp->in[19] + (size_t)l * DBR + q4), lnb = *(const f32x4*)(kp->in[20] + (size_t)l * DBR + q4);
#pragma unroll 8
            for (int t = bid * 2 + (tid >> 8); t < S_; t += 2 * G) {
                const size_t o = (size_t)t * DBR + q4;
                const f32x4 y = *(const f32x4*)(YRAW + o);
                const u32x2 rv = *(const u32x2*)(RV + o), gc = *(const u32x2*)(P + (size_t)t * NP + COL_GC + q4), ga = *(const u32x2*)(P + (size_t)t * NP + COL_GA + q4);
                const u32x2 hl = *(const u32x2*)(Ya + o), ac = *(const u32x2*)(ACUM + o);
                const f32x4 cin = *(const f32x4*)(CIN + (size_t)(t >> 6) * DBR + q4);
                const float bon = BON[(size_t)t * 16 + hh];
                const float mu = rowsum16((y[0] + y[1]) + (y[2] + y[3])) * (1.0f / 64.0f);
                const f32x4 d = y - mu;
                const float var = rowsum16((d[0] * d[0] + d[1] * d[1]) + (d[2] * d[2] + d[3] * d[3])) * (1.0f / 64.0f);
                const float rs = 1.0f / sqrtf(var + GN_EPS);
                const float y0 = (d[0] * rs * lnw[0] + lnb[0] + bon * bflo(rv.x)) * siluf_(bflo(gc.x)), y1 = (d[1] * rs * lnw[1] + lnb[1] + bon * bfhi(rv.x)) * siluf_(bfhi(gc.x));
                const float y2 = (d[2] * rs * lnw[2] + lnb[2] + bon * bflo(rv.y)) * siluf_(bflo(gc.y)), y3 = (d[3] * rs * lnw[3] + lnb[3] + bon * bfhi(rv.y)) * siluf_(bfhi(gc.y));
                u32x2 w; w.x = cvt_pk_bf16(y0, y1); w.y = cvt_pk_bf16(y2, y3);
                *(u32x2*)(Yc + o) = w;
                const float h0 = (bflo(hl.x) + bflo(ac.x) * cin[0]) * siluf_(bflo(ga.x)), h1 = (bfhi(hl.x) + bfhi(ac.x) * cin[1]) * siluf_(bfhi(ga.x));
                const float h2 = (bflo(hl.y) + bflo(ac.y) * cin[2]) * siluf_(bflo(ga.y)), h3 = (bfhi(hl.y) + bfhi(ac.y) * cin[3]) * siluf_(bfhi(ga.y));
                u32x2 w2; w2.x = cvt_pk_bf16(h0, h1); w2.y = cvt_pk_bf16(h2, h3);
                *(u32x2*)(Ya + o) = w2;
            }
        }
#endif
        GRID_BAR();
#if PHSEL(6)
        for (int rep = 0; rep < REP5; ++rep) { if (rep) GRID_BAR(); KP_FRESH(kp); TID_FRESH(); unsigned char* ws = kp->ws;
          pg8::Gemm g{(const bf16_t*)(ws + OFF_HY), (const bf16_t*)(ws + OFF_WSM + l * SZ_WSM_L), S_, DM, DBR, (size_t)S_ * DBR * 2, (size_t)DM * DBR * 2}; pg8::StaticOrder so; so.init(S_, DM, G, bid, 3);
          pg8::EpiMerge E{(bf16_t*)(ws + OFF_M), (const bf16_t*)(ws + OFF_P)};
          pg8::gemm_phase<pg8::EpiMerge, true>(lds, g, so, E); }
#endif
        GRID_BAR();
#if PHSEL(7)
        { KP_FRESH(kp); TID_FRESH(); unsigned char* ws = kp->ws;
          pg8::Gemm g{(const bf16_t*)(ws + OFF_M), (const bf16_t*)(ws + OFF_WSM + l * SZ_WSM_L + SZ_WBR), S_, DM, DM, 0, 0}; pg8::StaticOrder so; so.init(S_, DM, G, bid, 1);
          pg8::EpiOut E{(bf16_t*)(ws + OFF_MO), (float*)(ws + OFF_CTL) + CW_ROWSS + l * S_};
          pg8::gemm_phase<pg8::EpiOut>(lds, g, so, E); }
#endif
        GRID_BAR();
#if PHSEL(8)
        {
            KP_FRESH(kp); TID_FRESH(); unsigned char* ws = kp->ws;
            float* outp = kp->out;
            const float* xin = (l == 0) ? kp->in[0] : outp;
            const float* pw = kp->in[2] + (size_t)l * DM;
            const float* pre1 = kp->in[1] + DM;
            const float* rowss = (const float*)(ws + OFF_CTL) + CW_ROWSS + l * S_;
            const bf16_t* MO = (const bf16_t*)(ws + OFF_MO); bf16_t* H = (bf16_t*)(ws + OFF_HY);
#pragma unroll 2
            for (int row = gw; row < S_; row += NGW) {
                const float sc = 1.0f / sqrtf(rowss[row] * (1.0f / DM) + NORM_EPS);
                const f32x4* xr = (const f32x4*)(xin + (size_t)row * DM) + lane; const u32x2* mr = (const u32x2*)(MO + (size_t)row * DM) + lane;
                f32x4* orow = (f32x4*)(outp + (size_t)row * DM) + lane;
                f32x4 v[8]; float s = 0.f;
#pragma unroll
                for (int j = 0; j < 8; ++j) { const f32x4 xv = xr[64 * j]; const u32x2 mw = mr[64 * j]; const f32x4 pv = *((const f32x4*)pw + lane + 64 * j);
                    f32x4 o; o[0] = xv[0] + bflo(mw.x) * sc * pv[0]; o[1] = xv[1] + bfhi(mw.x) * sc * pv[1]; o[2] = xv[2] + bflo(mw.y) * sc * pv[2]; o[3] = xv[3] + bfhi(mw.y) * sc * pv[3];
                    orow[64 * j] = o; v[j] = o; s += (o[0] * o[0] + o[1] * o[1]) + (o[2] * o[2] + o[3] * o[3]); }
                if (l == 0) rms_row_store(v, wave_sum(s), pre1, H + (size_t)row * DM, lane);
            }
            if (l == 0) { __syncthreads(); convert_win(kp->in[3] + (size_t)DM * NIN, (bf16_t*)(ws + OFF_WIN), (LAS float*)(lds + wave * 16384), gw, NGW, lane); }
        }
#endif
        if (l == 0) GRID_BAR();
    }
}

extern "C" void kernel_launch(void* const* d_in, const int* in_sizes, int n_in, void* d_out, int out_size, void* d_ws, size_t ws_size, hipStream_t stream) {
    static int grid = 0;
    if (grid == 0) {
        if (n_in != 23 || out_size != S_ * DM || ws_size < WS_END) { fprintf(stderr, "kernel_launch: unexpected problem (n_in %d, out %d, ws %zu, need %zu)\n", n_in, out_size, ws_size, (size_t)WS_END); grid = -1; return; }
        int dev = 0, cus = 0, per_cu = 0;
        hipGetDevice(&dev);
        hipDeviceGetAttribute(&cus, hipDeviceAttributeMultiprocessorCount, dev);
        if (hipFuncSetAttribute((const void*)hybrid_fwd, hipFuncAttributeMaxDynamicSharedMemorySize, LDS_BYTES) != hipSuccess) { fprintf(stderr, "kernel_launch: hipFuncSetAttribute failed\n"); grid = -1; return; }
        hipOccupancyMaxActiveBlocksPerMultiprocessor(&per_cu, (const void*)hybrid_fwd, 512, LDS_BYTES);
        (void)hipGetLastError();
        if (per_cu < 1) per_cu = 1;
        grid = cus * per_cu;
        if (grid < N_RWKV_BLK + 8) { fprintf(stderr, "kernel_launch: grid %d too small\n", grid); grid = -1; return; }
    }
    if (grid < 0) return;
    Params p{};
    for (int i = 0; i < 23; ++i) p.in[i] = (const float*)d_in[i];
    p.out = (float*)d_out; p.ws = (unsigned char*)d_ws;
    void* args[] = {&p};
    hipError_t e = hipLaunchCooperativeKernel((const void*)hybrid_fwd, dim3(grid), dim3(512), args, LDS_BYTES, stream);
    if (e != hipSuccess) fprintf(stderr, "kernel_launch: cooperative launch failed: %s (grid %d)\n", hipGetErrorString(e), grid);
}
```

```cpp
#include <hip/hip_runtime.h>
#include <hip/hip_cooperative_groups.h>
#include <cstdio>
#include <cstdint>
namespace cg = cooperative_groups;

#define LAS __attribute__((address_space(3)))
typedef unsigned short bf16_t;
typedef short bf16x8 __attribute__((ext_vector_type(8)));
typedef float f32x2 __attribute__((ext_vector_type(2)));
typedef float f32x4 __attribute__((ext_vector_type(4)));
typedef float f32x16 __attribute__((ext_vector_type(16)));
typedef unsigned u32x2 __attribute__((ext_vector_type(2)));
typedef unsigned u32x4 __attribute__((ext_vector_type(4)));

constexpr int S_ = 16384, DM = 2048, NP = 16640, NIN = 16520, DBR = 1024;
constexpr int COL_PC = 0, COL_FL = 3200, COL_GC = 3328, COL_XA = 4352, COL_GA = 5376, COL_Q = 6400, COL_K = 7424, COL_V = 8448, COL_GB = 9472, COL_MG = 10496;
constexpr int NA = 3328;
constexpr int NFILL = 768;
constexpr float NORM_EPS = 1e-6f, GN_EPS = 64e-5f, LOG2E = 1.4426950408889634f;
constexpr int LDS_BYTES = 147456;
constexpr int N_RWKV_BLK = 64;

constexpr size_t OFF_CTL = 0, CTL_BYTES = 1u << 20;
constexpr size_t OFF_P = CTL_BYTES;
constexpr size_t SZ_P = (size_t)S_ * NP * 2;
constexpr size_t OFF_WIN = OFF_P + SZ_P;
constexpr size_t SZ_WIN = (size_t)NP * DM * 2;
constexpr size_t OFF_VT = OFF_WIN;
constexpr size_t OFF_C = OFF_WIN + (size_t)8 * 128 * S_ * 2;
constexpr size_t OFF_WSM = OFF_WIN + SZ_WIN;
constexpr size_t SZ_WBR = (size_t)3 * DM * DBR * 2, SZ_WOUT = (size_t)DM * DM * 2, SZ_WGT = (size_t)2 * 16 * 64 * 64 * 2;
constexpr size_t SZ_WLORA = (size_t)2 * DBR * 64 * 2;
constexpr size_t SZ_WSM_L = SZ_WBR + SZ_WOUT + SZ_WGT + SZ_WLORA;
constexpr size_t OFF_HY = OFF_WSM + 2 * SZ_WSM_L;
constexpr size_t SZ_Y1 = (size_t)S_ * DBR * 2;
constexpr size_t OFF_RW = OFF_HY + 3 * SZ_Y1;
constexpr size_t SZ_DEC = (size_t)S_ * DBR * 4;
constexpr size_t OFF_M = OFF_RW, OFF_MO = OFF_RW + (size_t)S_ * DM * 2;
constexpr size_t OFF_BON = OFF_RW + SZ_DEC + 5 * SZ_Y1;
constexpr size_t OFF_YRAW = OFF_BON + (size_t)S_ * 16 * 4;
constexpr size_t OFF_AGA = OFF_YRAW + (size_t)S_ * DBR * 4;
constexpr size_t OFF_AGB = OFF_AGA + (1u << 20);
constexpr size_t OFF_CIN = OFF_AGB + (1u << 20);
constexpr size_t OFF_TS = OFF_CIN + (1u << 20);
constexpr size_t WS_END = OFF_TS + (1u << 16);
constexpr size_t OFF_ACUM = OFF_C + (size_t)8 * S_ * 4;
static_assert(OFF_ACUM + (size_t)S_ * DBR * 2 <= OFF_WSM, "ACUM fits behind VT and C");
constexpr int CW_ATTN = 0;
constexpr int CW_ROWSS = 4096;
constexpr int CW_KN = 3072;
constexpr int CW_PB = 2048;

__device__ __forceinline__ float bf2f(unsigned b) { return __uint_as_float(b << 16); }
__device__ __forceinline__ float bflo(unsigned w) { return __uint_as_float(w << 16); }
__device__ __forceinline__ float bfhi(unsigned w) { return __uint_as_float(w & 0xffff0000u); }
__device__ __forceinline__ unsigned f2bf(float f) { unsigned u = __float_as_uint(f); return (u + 0x7fffu + ((u >> 16) & 1u)) >> 16; }
__device__ __forceinline__ unsigned pk2(float lo, float hi) { return f2bf(lo) | (f2bf(hi) << 16); }
__device__ __forceinline__ unsigned cvt_pk_bf16(float lo, float hi) { unsigned r; asm volatile("v_cvt_pk_bf16_f32 %0, %1, %2" : "=v"(r) : "v"(lo), "v"(hi)); return r; }
__device__ __forceinline__ float sigmoidf_(float x) { return 1.0f / (1.0f + __expf(-x)); }
__device__ __forceinline__ float siluf_(float x) { return x / (1.0f + __expf(-x)); }
__device__ __forceinline__ float softplusf_(float x) { return fmaxf(x, 0.f) + log1pf(expf(-fabsf(x))); }
__device__ __forceinline__ float logsigf_(float x) { return fminf(x, 0.f) - log1pf(expf(-fabsf(x))); }
__device__ __forceinline__ int fresh_tid() { int t = threadIdx.x; asm volatile("" : "+v"(t)); return t; }
#define LDS_WAIT() asm volatile("s_waitcnt lgkmcnt(0)" ::: "memory")
template <int CTRL> __device__ __forceinline__ float dppf(float x) { return __int_as_float(__builtin_amdgcn_update_dpp(0, __float_as_int(x), CTRL, 0xf, 0xf, true)); }
__device__ __forceinline__ float rowsum16(float x) {
    x += dppf<0xB1>(x); x += dppf<0x4E>(x); x += dppf<0x141>(x); x += dppf<0x140>(x); return x;
}

__device__ __forceinline__ float wave_sum(float v) { v = rowsum16(v); v += __shfl_xor(v, 16); v += __shfl_xor(v, 32); return v; }

__device__ __forceinline__ void part_barrier(unsigned* ctr, unsigned target) {
    asm volatile("s_waitcnt vmcnt(0)" ::: "memory");
    __syncthreads();
    if (threadIdx.x == 0) {
        __threadfence();
        __hip_atomic_fetch_add(ctr, 1u, __ATOMIC_RELEASE, __HIP_MEMORY_SCOPE_AGENT);
        while (__hip_atomic_load(ctr, __ATOMIC_ACQUIRE, __HIP_MEMORY_SCOPE_AGENT) < target) __builtin_amdgcn_s_sleep(2);
        __threadfence();
    }
    __syncthreads();
}
__device__ __forceinline__ void part_wait(unsigned* ctr, unsigned target) {
    __syncthreads();
    if (threadIdx.x == 0) { while (__hip_atomic_load(ctr, __ATOMIC_ACQUIRE, __HIP_MEMORY_SCOPE_AGENT) < target) __builtin_amdgcn_s_sleep(2); __threadfence(); }
    __syncthreads();
}


#define XB_TMO      128
#define XB_XCNT(j)  (256  + 64 * (j))
#define XB_XSUB(j)  (1280 + 64 * (j))
#define XB_XGEN(j)  (2304 + 64 * (j))
#define XB_TOP      3328
#define XB_TOPGEN   3392
#define XCD_BAR_WORDS 3456
#define XB_SPIN_CAP (1u << 22)
__device__ __forceinline__ unsigned xb_ld(unsigned* p)              { return __hip_atomic_load(p, __ATOMIC_RELAXED, __HIP_MEMORY_SCOPE_AGENT); }
__device__ __forceinline__ unsigned xb_add(unsigned* p, unsigned v) { return __hip_atomic_fetch_add(p, v, __ATOMIC_RELAXED, __HIP_MEMORY_SCOPE_AGENT); }
__device__ __forceinline__ unsigned xb_xcc_id() { return (unsigned)__builtin_amdgcn_s_getreg((3 << 11) | 20) & 0xFu; }
#define XB_SPIN(cond, bar) do { unsigned _sp = 0; while (cond) { __builtin_amdgcn_s_sleep(1); \
    if ((++_sp & 255u) == 0u) { if (xb_ld(&(bar)[XB_TMO])) break; if (_sp > XB_SPIN_CAP) { atomicAdd(&(bar)[XB_TMO], 1u); break; } } } } while (0)
struct XcdBarrier { unsigned* bar; unsigned x; volatile LAS unsigned* st; };
__device__ __forceinline__ void xcd_barrier_complete(unsigned* bar, unsigned x, unsigned& nloc, unsigned& nx) {
    const unsigned G = gridDim.x * gridDim.y * gridDim.z;
    unsigned sum, cnt, mine, sp = 0u;
    for (;;) {
        sum = 0u; cnt = 0u; mine = 0u;
#pragma unroll
        for (unsigned j = 0; j < 16; ++j) { const unsigned c = xb_ld(&bar[XB_XCNT(j)]); sum += c; cnt += (c > 0u) ? 1u : 0u; mine = (j == x) ? c : mine; }
        if (sum == G) break;
        __builtin_amdgcn_s_sleep(1);
        if ((++sp & 255u) == 0u) { if (xb_ld(&bar[XB_TMO])) break; if (sp > XB_SPIN_CAP) { atomicAdd(&bar[XB_TMO], 1u); break; } }
    }
    nloc = mine > 0u ? mine : 1u; nx = cnt > 0u ? cnt : 1u;
}
__device__ __forceinline__ void xcd_barrier(const XcdBarrier& b) {
    asm volatile("s_waitcnt vmcnt(0)" ::: "memory");
    __syncthreads();
    if (threadIdx.x == 0) {
        unsigned* bar = b.bar;
        __builtin_amdgcn_s_waitcnt(0);
        unsigned nloc = b.st[0], nx = b.st[1];
        if (nloc == 0u) { xcd_barrier_complete(bar, b.x, nloc, nx); b.st[0] = nloc; b.st[1] = nx; }
        const unsigned old = xb_add(&bar[XB_XSUB(b.x)], 1u);
        const unsigned gen = old / nloc;
        if (old + 1u == (gen + 1u) * nloc) {
            __builtin_amdgcn_fence(__ATOMIC_RELEASE, "agent");
            asm volatile("s_waitcnt vmcnt(0)" ::: "memory");
            const unsigned og = xb_add(&bar[XB_TOP], 1u);
            const unsigned tg = og / nx;
            if (og + 1u == (tg + 1u) * nx) xb_add(&bar[XB_TOPGEN], 1u);
            else XB_SPIN(xb_ld(&bar[XB_TOPGEN]) == tg, bar);
            __builtin_amdgcn_fence(__ATOMIC_ACQUIRE, "agent");
            xb_add(&bar[XB_XGEN(b.x)], 1u);
            asm volatile("s_waitcnt vmcnt(0)" ::: "memory");
        } else {
            XB_SPIN(xb_ld(&bar[XB_XGEN(b.x)]) == gen, bar);
            __builtin_amdgcn_fence(__ATOMIC_ACQUIRE, "agent");
            asm volatile("s_waitcnt vmcnt(0)" ::: "memory");
        }
    }
    __syncthreads();
}
constexpr int CW_XBAR = 40960;
constexpr int XB_ST_OFF = 144 * 1024 - 32;

namespace pg8 {
constexpr int BM = 256, BK = 64, HALF = 128, HTB = HALF * BK * 2, STAGE_BYTES = 8 * HTB, NXCD = 8, WGM = 8;
__host__ __device__ __forceinline__ int lds_byte(int r, int c) { const int st = (r >> 4) * 2 + (c >> 5), rr = r & 15, cc = c & 31, ob = rr * 64 + cc * 2; return st * 1024 + (ob ^ (((ob >> 9) & 1) << 5)); }
__host__ __device__ __forceinline__ void stage_rc(int b, int& R, int& C) { const int st = b / 1024, sb = b % 1024, swz = sb ^ (((sb >> 9) & 1) << 5); R = (st >> 1) * 16 + swz / 64; C = (st & 1) * 32 + (swz % 64) / 2; }
__host__ __device__ __forceinline__ int perm32(int rho) { const int n = rho >> 4, i = rho & 15; return 8 * (i >> 2) + 4 * n + (i & 3); }

struct Unit { int pm, pn, z; };
struct Gemm { const bf16_t* A; const bf16_t* Bt; int M, N, K; size_t zA, zB; };

struct StaticOrder {
    int nM, nN, nwg, G, c, nz;
    __device__ void init(int M, int N, int G_, int c_, int nz_) { nM = M / BM; nN = N / BM; nwg = nM * nN; G = G_; c = c_; nz = nz_; }
    __device__ bool next(int i, Unit& u) const {
        const int ti = i / nz; u.z = i - ti * nz;
        const long L = (long)ti * G + c; if (L >= nwg) return false;
        int wgid = (int)L; { const int q = nwg / NXCD, r = nwg % NXCD, xcd = wgid % NXCD, off = wgid / NXCD; wgid = (xcd < r ? xcd * (q + 1) : r * (q + 1) + (xcd - r) * q) + off; }
        const int nig = WGM * nN, gid = wgid / nig, fm = gid * WGM, gsz = (nM - fm) < WGM ? (nM - fm) : WGM;
        u.pm = fm + ((wgid % nig) % gsz); u.pn = (wgid % nig) / gsz; return true;
    }
};

struct EpiStore {
    bf16_t* O; int ldc;
    __device__ __forceinline__ void operator()(const f32x4 (&acc)[2][2][4][2], const Unit& u, int wr, int wc, int fr, int fq) const {
        const int row0 = u.pm * BM + wr * 64 + fr, col0 = u.pn * BM + wc * 32 + 8 * fq;
#pragma unroll
        for (int ai = 0; ai < 2; ++ai)
#pragma unroll
            for (int m = 0; m < 4; ++m) { bf16_t* rowp = O + (size_t)(row0 + ai * HALF + m * 16) * ldc + col0;
#pragma unroll
                for (int bj = 0; bj < 2; ++bj) { const f32x4 v0 = acc[ai][bj][m][0], v1 = acc[ai][bj][m][1];
                    u32x4 w; w.x = cvt_pk_bf16(v0[0], v0[1]); w.y = cvt_pk_bf16(v0[2], v0[3]); w.z = cvt_pk_bf16(v1[0], v1[1]); w.w = cvt_pk_bf16(v1[2], v1[3]);
                    *(u32x4*)(rowp + bj * HALF) = w; } }
    }
};
struct EpiStoreGate {
    bf16_t* O; int ldc; int tile0; const float* bmerge;
    __device__ __forceinline__ void operator()(const f32x4 (&acc)[2][2][4][2], const Unit& u, int wr, int wc, int fr, int fq) const {
        const int row0 = u.pm * BM + wr * 64 + fr, col0 = u.pn * BM + wc * 32 + 8 * fq;
        const bool gate = u.pn >= tile0;
#pragma unroll
        for (int bj = 0; bj < 2; ++bj) {
            f32x4 b0 = {0.f, 0.f, 0.f, 0.f}, b1 = {0.f, 0.f, 0.f, 0.f};
            if (gate) { const float* bp = bmerge + (u.pn - tile0) * BM + wc * 32 + 8 * fq + bj * HALF; b0 = *(const f32x4*)bp; b1 = *(const f32x4*)(bp + 4); }
#pragma unroll
            for (int ai = 0; ai < 2; ++ai)
#pragma unroll
                for (int m = 0; m < 4; ++m) { bf16_t* rowp = O + (size_t)(row0 + ai * HALF + m * 16) * ldc + col0 + bj * HALF;
                    f32x4 v0 = acc[ai][bj][m][0], v1 = acc[ai][bj][m][1];
                    if (gate) { v0 = v0 + b0; v1 = v1 + b1;
                        v0[0] = sigmoidf_(v0[0]); v0[1] = sigmoidf_(v0[1]); v0[2] = sigmoidf_(v0[2]); v0[3] = sigmoidf_(v0[3]);
                        v1[0] = sigmoidf_(v1[0]); v1[1] = sigmoidf_(v1[1]); v1[2] = sigmoidf_(v1[2]); v1[3] = sigmoidf_(v1[3]); }
                    u32x4 w; w.x = cvt_pk_bf16(v0[0], v0[1]); w.y = cvt_pk_bf16(v0[2], v0[3]); w.z = cvt_pk_bf16(v1[0], v1[1]); w.w = cvt_pk_bf16(v1[2], v1[3]);
                    *(u32x4*)rowp = w; }
        }
    }
};
struct EpiMerge {
    bf16_t* Mo; const bf16_t* P;
    __device__ __forceinline__ void operator()(f32x4 (&acc)[2][2][4][2], const Unit& u, int wr, int wc, int fr, int fq) const {
        const int row0 = u.pm * BM + wr * 64 + fr, col0 = u.pn * BM + wc * 32 + 8 * fq;
        const int z = u.z;
#pragma unroll
        for (int bj = 0; bj < 2; ++bj) {
            const int col = col0 + bj * HALF;
#pragma unroll
            for (int ai = 0; ai < 2; ++ai)
#pragma unroll
                for (int m = 0; m < 4; ++m) {
                    const int row = row0 + ai * HALF + m * 16;
                    const bf16_t* gp = P + (size_t)row * NP + COL_MG + z * DM + col;
                    const u32x4 g = *(const u32x4*)gp;
                    float r[8] = {bflo(g.x), bfhi(g.x), bflo(g.y), bfhi(g.y), bflo(g.z), bfhi(g.z), bflo(g.w), bfhi(g.w)};
#pragma unroll
                    for (int e = 0; e < 8; ++e) r[e] = fmaxf(r[e], 1e-30f);
                    if (z < 2) { const u32x4 h = *(const u32x4*)(gp + DM);
                        const float d[8] = {bflo(h.x), bfhi(h.x), bflo(h.y), bfhi(h.y), bflo(h.z), bfhi(h.z), bflo(h.w), bfhi(h.w)};
#pragma unroll
                        for (int e = 0; e < 8; ++e) r[e] *= __builtin_amdgcn_rcpf(fmaxf(d[e], 1e-30f)); }
                    f32x4& v0 = acc[ai][bj][m][0]; f32x4& v1 = acc[ai][bj][m][1];
                    v0[0] *= r[0]; v0[1] *= r[1]; v0[2] *= r[2]; v0[3] *= r[3]; v1[0] *= r[4]; v1[1] *= r[5]; v1[2] *= r[6]; v1[3] *= r[7];
                    if (z == 2) { u32x4 w; w.x = cvt_pk_bf16(v0[0], v0[1]); w.y = cvt_pk_bf16(v0[2], v0[3]); w.z = cvt_pk_bf16(v1[0], v1[1]); w.w = cvt_pk_bf16(v1[2], v1[3]);
                        *(u32x4*)(Mo + (size_t)row * DM + col) = w; }
                }
        }
    }
};
struct EpiOut {
    bf16_t* O; float* rowss;
    __device__ __forceinline__ void operator()(const f32x4 (&acc)[2][2][4][2], const Unit& u, int wr, int wc, int fr, int fq) const {
        const int row0 = u.pm * BM + wr * 64 + fr, col0 = u.pn * BM + wc * 32 + 8 * fq;
#pragma unroll
        for (int ai = 0; ai < 2; ++ai)
#pragma unroll
            for (int m = 0; m < 4; ++m) { const int row = row0 + ai * HALF + m * 16; bf16_t* rowp = O + (size_t)row * DM + col0; float s = 0.f;
#pragma unroll
                for (int bj = 0; bj < 2; ++bj) { const f32x4 v0 = acc[ai][bj][m][0], v1 = acc[ai][bj][m][1];
                    s += (v0[0] * v0[0] + v0[1] * v0[1]) + (v0[2] * v0[2] + v0[3] * v0[3]) + (v1[0] * v1[0] + v1[1] * v1[1]) + (v1[2] * v1[2] + v1[3] * v1[3]);
                    u32x4 w; w.x = cvt_pk_bf16(v0[0], v0[1]); w.y = cvt_pk_bf16(v0[2], v0[3]); w.z = cvt_pk_bf16(v1[0], v1[1]); w.w = cvt_pk_bf16(v1[2], v1[3]);
                    *(u32x4*)(rowp + bj * HALF) = w; }
                s += __shfl_xor(s, 16); s += __shfl_xor(s, 32);
                if (fq == 0) atomicAdd(rowss + row, s); }
    }
};

template <class Epi, bool KEEP_Z = false>
__device__ __forceinline__ void gemm_phase(LAS unsigned char* lds, const Gemm g, const StaticOrder& S, const Epi& E) {
    const int tid = fresh_tid(), wid = __builtin_amdgcn_readfirstlane(tid >> 6), lane = tid & 63, wr = wid >> 2, wc = wid & 3, fr = lane & 15, fq = lane >> 4;
    const int K = g.K, nt = K / BK;
    unsigned voffA[2], voffB[2];
#pragma unroll
    for (int i = 0; i < 2; ++i) { int R, C; stage_rc(tid * 16 + i * 8192, R, C); const int Rb = (R & ~31) + perm32(R & 31);
        voffA[i] = (unsigned)(R * K + C) * 2u; voffB[i] = (unsigned)(Rb * K + C) * 2u; }
    const size_t kstep = (size_t)(BK * 2);
    const size_t hstep = (size_t)HALF * K * 2;
    const size_t tstep = 2 * hstep;
    const unsigned ldsw = (unsigned)wid * 1024u;
    const int aoff = lds_byte(wr * 64 + fr, fq * 8), boff = lds_byte(wc * 32 + fr, fq * 8);
#define PG8_SA(b, h) (((b) * 2 + (h)) * HTB)
#define PG8_SB(b, h) ((4 + (b) * 2 + (h)) * HTB)
#define PG8_STAGE(bufoff, gbase, voff) do { _Pragma("unroll") for (int _i = 0; _i < 2; ++_i) \
        __builtin_amdgcn_global_load_lds((const unsigned*)((const char*)(gbase) + (voff)[_i]), (LAS unsigned*)(lds + (bufoff) + ldsw + _i * 8192), 16, 0, 0); } while (0)
#define PG8_LDA(dst, b, h) do { _Pragma("unroll") for (int m = 0; m < 4; ++m) _Pragma("unroll") for (int k = 0; k < 2; ++k) dst[m][k] = *(const LAS bf16x8*)(lds + PG8_SA(b, h) + aoff + m * 2048 + k * 1024); } while (0)
#define PG8_LDB(dst, b, h) do { _Pragma("unroll") for (int n = 0; n < 2; ++n) _Pragma("unroll") for (int k = 0; k < 2; ++k) dst[n][k] = *(const LAS bf16x8*)(lds + PG8_SB(b, h) + boff + n * 2048 + k * 1024); } while (0)
#define PG8_MMA(ai, bj, At, Bt) do { __builtin_amdgcn_s_setprio(1); _Pragma("unroll") for (int m = 0; m < 4; ++m) _Pragma("unroll") for (int n = 0; n < 2; ++n) _Pragma("unroll") for (int k = 0; k < 2; ++k) \
        acc[ai][bj][m][n] = __builtin_amdgcn_mfma_f32_16x16x32_bf16(Bt[n][k], At[m][k], acc[ai][bj][m][n], 0, 0, 0); __builtin_amdgcn_s_setprio(0); } while (0)
#define PG8_WAIT_V(n) asm volatile("s_waitcnt vmcnt(" #n ")" ::: "memory")
#define PG8_WAIT_L(n) asm volatile("s_waitcnt lgkmcnt(" #n ")" ::: "memory")
#define PG8_BAR __builtin_amdgcn_s_barrier()
#define PG8_SCHED __builtin_amdgcn_sched_barrier(0)
    Unit cur, nxt; int ui = 0;
    if (!S.next(0, cur)) return;
    f32x4 acc[2][2][4][2];
#pragma unroll
    for (int a = 0; a < 2; ++a)
#pragma unroll
        for (int b = 0; b < 2; ++b)
#pragma unroll
            for (int m = 0; m < 4; ++m)
#pragma unroll
                for (int n = 0; n < 2; ++n) acc[a][b][m][n] = (f32x4){0.f, 0.f, 0.f, 0.f};
    bf16x8 At[4][2], B0[2][2], B1[2][2];
    const char* cA = (const char*)g.A + (size_t)cur.pm * tstep + (size_t)cur.z * g.zA; const char* cB = (const char*)g.Bt + (size_t)cur.pn * tstep + (size_t)cur.z * g.zB;
    {
        PG8_STAGE(PG8_SB(0, 0), cB, voffB); PG8_STAGE(PG8_SB(0, 1), cB + hstep, voffB); PG8_STAGE(PG8_SA(0, 0), cA, voffA); PG8_STAGE(PG8_SA(0, 1), cA + hstep, voffA);
        if (wr == 1) PG8_BAR;
        PG8_WAIT_V(2); PG8_BAR;
        PG8_STAGE(PG8_SB(1, 0), cB + kstep, voffB); PG8_STAGE(PG8_SA(1, 0), cA + kstep, voffA); PG8_STAGE(PG8_SB(1, 1), cB + hstep + kstep, voffB);
        PG8_WAIT_V(6); PG8_BAR;
    }
    for (;;) {
        const bool has_next = S.next(ui + 1, nxt);
        const char* nA = has_next ? (const char*)g.A + (size_t)nxt.pm * tstep + (size_t)nxt.z * g.zA : cA; const char* nB = has_next ? (const char*)g.Bt + (size_t)nxt.pn * tstep + (size_t)nxt.z * g.zB : cB;
        for (int t = 0; t < nt; t += 2) {
            const bool last = (t == nt - 2);
            const char* a1 = cA + (size_t)(t + 1) * kstep;
            const char* a2 = last ? nA : cA + (size_t)(t + 2) * kstep; const char* b2 = last ? nB : cB + (size_t)(t + 2) * kstep;
            const char* a3 = a2 + kstep; const char* b3 = b2 + kstep;
            PG8_LDB(B0, 0, 0); PG8_LDB(B1, 0, 1); PG8_SCHED; PG8_LDA(At, 0, 0); PG8_STAGE(PG8_SA(1, 1), a1 + hstep, voffA);
            PG8_WAIT_V(8); PG8_WAIT_L(0); PG8_BAR; PG8_MMA(0, 0, At, B0); PG8_MMA(0, 1, At, B1); PG8_BAR; PG8_SCHED;
            PG8_LDA(At, 0, 1); PG8_STAGE(PG8_SB(0, 0), b2, voffB); PG8_STAGE(PG8_SB(0, 1), b2 + hstep, voffB); PG8_STAGE(PG8_SA(0, 0), a2, voffA);
            PG8_WAIT_V(8); PG8_WAIT_L(0); PG8_BAR; PG8_MMA(1, 0, At, B0); PG8_MMA(1, 1, At, B1); PG8_BAR; PG8_SCHED;
            PG8_LDB(B0, 1, 0); PG8_LDB(B1, 1, 1); PG8_SCHED; PG8_LDA(At, 1, 0); PG8_STAGE(PG8_SA(0, 1), a2 + hstep, voffA);
            PG8_WAIT_V(8); PG8_WAIT_L(0); PG8_BAR; PG8_MMA(0, 0, At, B0); PG8_MMA(0, 1, At, B1); PG8_BAR; PG8_SCHED;
            PG8_LDA(At, 1, 1); PG8_STAGE(PG8_SB(1, 0), b3, voffB); PG8_STAGE(PG8_SB(1, 1), b3 + hstep, voffB); PG8_STAGE(PG8_SA(1, 0), a3, voffA);
            PG8_WAIT_V(8); PG8_WAIT_L(0); PG8_BAR; PG8_MMA(1, 0, At, B0); PG8_MMA(1, 1, At, B1); PG8_BAR; PG8_SCHED;
        }
        if (wr == 0) PG8_BAR;
        E(acc, cur, wr, wc, fr, fq);
        if (!has_next) break;
        if (!KEEP_Z || nxt.z == 0) {
#pragma unroll
        for (int a = 0; a < 2; ++a)
#pragma unroll
            for (int b = 0; b < 2; ++b)
#pragma unroll
                for (int m = 0; m < 4; ++m)
#pragma unroll
                    for (int n = 0; n < 2; ++n) acc[a][b][m][n] = (f32x4){0.f, 0.f, 0.f, 0.f};
        }
        cur = nxt; cA = nA; cB = nB; ++ui;
        if (wr == 1) PG8_BAR;
    }
    PG8_WAIT_V(0);
    PG8_BAR;
#undef PG8_SA
#undef PG8_SB
#undef PG8_STAGE
#undef PG8_LDA
#undef PG8_LDB
#undef PG8_MMA
#undef PG8_WAIT_V
#undef PG8_WAIT_L
#undef PG8_BAR
#undef PG8_SCHED
}
}

struct Params {
    const float* in[23];
    float* out;
    unsigned char* ws;
};

__device__ __forceinline__ int map_in(int d) {
    if (d < 3200) return 6152 + d; if (d < 3208) return 5120 + (d - 3200); if (d < 3328) return -1; if (d < 4352) return 9352 + (d - 3328);
    if (d < 9472) return d - 4352; if (d < 10496) return 5128 + (d - 9472); return 10376 + (d - 10496); }
template <bool MAP>
__device__ __forceinline__ void transpose_item(const float* W, int K, int Nsrc, bf16_t* WT, LAS float* scr, int item, int nblk, int lane) {
    const int kb = item / nblk, nb = item - kb * nblk, k0 = 64 * kb, n0 = 32 * nb;
    if (MAP && n0 == COL_FL) {
        const int d = n0 + (lane & 31); const int sc = map_in(d);
#pragma unroll 8
        for (int i = 0; i < 32; ++i) { const int kk = 2 * i + (lane >> 5); scr[kk * 33 + (lane & 31)] = (sc >= 0) ? W[(size_t)(k0 + kk) * Nsrc + sc] : 0.f; }
    } else {
        const int sc0 = MAP ? map_in(n0) : n0;
        const int r8 = lane >> 3, c4 = lane & 7;
        f32x4 v[8];
#pragma unroll
        for (int i = 0; i < 8; ++i) v[i] = (sc0 >= 0) ? *(const f32x4*)(W + (size_t)(k0 + 8 * i + r8) * Nsrc + sc0 + 4 * c4) : (f32x4){0.f, 0.f, 0.f, 0.f};
#pragma unroll
        for (int i = 0; i < 8; ++i) { LAS float* d = scr + (8 * i + r8) * 33 + 4 * c4; d[0] = v[i][0]; d[1] = v[i][1]; d[2] = v[i][2]; d[3] = v[i][3]; }
    }
    LDS_WAIT(); asm volatile("" ::: "memory");
    const int c = lane & 7;
#pragma unroll
    for (int j = 0; j < 4; ++j) { const int n = (lane >> 3) + 8 * j; const LAS float* s = scr + (8 * c) * 33 + n;
        u32x4 o; o.x = pk2(s[0 * 33], s[1 * 33]); o.y = pk2(s[2 * 33], s[3 * 33]); o.z = pk2(s[4 * 33], s[5 * 33]); o.w = pk2(s[6 * 33], s[7 * 33]);
        *(u32x4*)(WT + (size_t)(n0 + n) * K + k0 + 8 * c) = o; }
    LDS_WAIT(); asm volatile("" ::: "memory");
}
__device__ __forceinline__ void convert_win(const float* w_in_l, bf16_t* WIN, LAS float* scr, int gw, int NGW, int lane) {
    constexpr int NBLK = NP / 32, NITEMS = (DM / 64) * NBLK;
    for (int it = gw; it < NITEMS; it += NGW) transpose_item<true>(w_in_l, DM, NIN, WIN, scr, it, NBLK, lane);
}
__device__ __forceinline__ void rms_row_store(const f32x4 (&v)[8], float ssum, const float* g, bf16_t* orow, int lane) {
    const float rs = 1.0f / sqrtf(ssum * (1.0f / DM) + NORM_EPS);
#pragma unroll
    for (int j = 0; j < 8; ++j) { const f32x4 gv = *((const f32x4*)g + lane + 64 * j);
        u32x2 w; w.x = pk2(v[j][0] * rs * gv[0], v[j][1] * rs * gv[1]); w.y = pk2(v[j][2] * rs * gv[2], v[j][3] * rs * gv[3]);
        *((u32x2*)orow + lane + 64 * j) = w; }
}

__device__ __forceinline__ void rms_row_store_g(const f32x4 (&v)[8], float ssum, const f32x4 (&gv)[8], bf16_t* orow, int lane) {
    const float rs = 1.0f / sqrtf(ssum * (1.0f / DM) + NORM_EPS);
#pragma unroll
    for (int j = 0; j < 8; ++j) { u32x2 w; w.x = pk2(v[j][0] * rs * gv[j][0], v[j][1] * rs * gv[j][1]); w.y = pk2(v[j][2] * rs * gv[j][2], v[j][3] * rs * gv[j][3]);
        *((u32x2*)orow + lane + 64 * j) = w; }
}

__device__ __forceinline__ void vt_unit(LAS unsigned char* lds, const bf16_t* P, bf16_t* Vt, const float* bfp, float* LSP, float* TS, unsigned* KN, int unit, int tid) {
    const int h = unit & 7, t0 = (unit >> 3) * 64;
    {
        const u32x4* kp = (const u32x4*)(P + (size_t)(t0 + (tid >> 3)) * NP + COL_K + h * 128 + (tid & 7) * 16);
        const u32x4 a = kp[0], b = kp[1]; float ss = 0.f;
        ss += bflo(a.x) * bflo(a.x) + bfhi(a.x) * bfhi(a.x) + bflo(a.y) * bflo(a.y) + bfhi(a.y) * bfhi(a.y) + bflo(a.z) * bflo(a.z) + bfhi(a.z) * bfhi(a.z) + bflo(a.w) * bflo(a.w) + bfhi(a.w) * bfhi(a.w);
        ss += bflo(b.x) * bflo(b.x) + bfhi(b.x) * bfhi(b.x) + bflo(b.y) * bflo(b.y) + bfhi(b.y) * bfhi(b.y) + bflo(b.z) * bflo(b.z) + bfhi(b.z) * bfhi(b.z) + bflo(b.w) * bflo(b.w) + bfhi(b.w) * bfhi(b.w);
        ss += dppf<0xB1>(ss); ss += dppf<0x4E>(ss); ss += dppf<0x141>(ss);
        ss = fmaxf(ss, __shfl_xor(ss, 8)); ss = fmaxf(ss, __shfl_xor(ss, 16)); ss = fmaxf(ss, __shfl_xor(ss, 32));
        if ((tid & 63) == 0) atomicMax(KN + h, __float_as_uint(ss));
    }
    if (tid < 64) {
        float x = logsigf_(bf2f(P[(size_t)(t0 + tid) * NP + COL_FL + h]) + bfp[h]);
#pragma unroll
        for (int o = 1; o < 64; o <<= 1) { const float y = __shfl_up(x, o); if (tid >= o) x += y; }
        LSP[(size_t)h * S_ + t0 + tid] = x; if (tid == 63) TS[h * 256 + (unit >> 3)] = x;
    }
    LAS unsigned short* T = (LAS unsigned short*)lds;
#pragma unroll
    for (int i = 0; i < 2; ++i) { const int id = tid + 512 * i, row = id >> 4, c16 = id & 15;
        const u32x4 v = *(const u32x4*)(P + (size_t)(t0 + row) * NP + COL_V + h * 128 + c16 * 8);
        LAS unsigned* dst = (LAS unsigned*)(T + row * 130 + c16 * 8); dst[0] = v.x; dst[1] = v.y; dst[2] = v.z; dst[3] = v.w; }
    __syncthreads();
#pragma unroll
    for (int i = 0; i < 2; ++i) { const int id = tid + 512 * i, d = id >> 3, t8 = id & 7;
        const LAS unsigned short* s = T + (t8 * 8) * 130 + d;
        u32x4 o; o.x = (unsigned)s[0] | ((unsigned)s[130] << 16); o.y = (unsigned)s[2 * 130] | ((unsigned)s[3 * 130] << 16);
        o.z = (unsigned)s[4 * 130] | ((unsigned)s[5 * 130] << 16); o.w = (unsigned)s[6 * 130] | ((unsigned)s[7 * 130] << 16);
        *(u32x4*)(Vt + (size_t)(h * 128 + d) * S_ + t0 + t8 * 8) = o; }
    __syncthreads();
}
struct RwkvW { const float *mu, *w0, *a0, *k_k, *k_a, *r_k; const bf16_t *wupt, *aupt; };
__device__ __forceinline__ void rwkv_prep_unit(LAS unsigned char* lds, const bf16_t* P, const RwkvW& W, float* decay, bf16_t* okk, bf16_t* ob, bf16_t* ok, bf16_t* orr, bf16_t* ov, float* bonus, int unit, int tid) {
    LAS unsigned short* X = (LAS unsigned short*)lds;
    LAS unsigned short* tw = X + 17 * 3200;
    LAS unsigned short* ca = tw + 16 * 72;
    const int t0 = unit * 16, wave = tid >> 6, lane = tid & 63, fr = lane & 15, fq = lane >> 4;
    {
        u32x4 v[14];
#pragma unroll
        for (int i = 0; i < 14; ++i) { const int id = tid + 512 * i; const int row = id / 400, ch = id - row * 400; const int t = t0 - 1 + row;
            v[i] = (u32x4){0u, 0u, 0u, 0u};
            if (id < 6800 && t >= 0) v[i] = *(const u32x4*)(P + (size_t)t * NP + COL_PC + ch * 8); }
#pragma unroll
        for (int i = 0; i < 14; ++i) { const int id = tid + 512 * i; const int row = id / 400, ch = id - row * 400;
            if (id < 6800) *(LAS u32x4*)(X + row * 3200 + ch * 8) = v[i]; }
    }
    __syncthreads();
#pragma unroll
    for (int i = 0; i < 4; ++i) { const int e = tid + 512 * i, tt = e >> 7, j = e & 127, col = 3072 + j;
        const float cur = bf2f(X[(tt + 1) * 3200 + col]), prev = bf2f(X[tt * 3200 + col]);
        const float xs = cur + (prev - cur) * W.mu[col];
        if (j < 64) tw[tt * 72 + j] = (unsigned short)f2bf(tanhf(xs)); else ca[tt * 72 + j - 64] = (unsigned short)f2bf(xs); }
    __syncthreads();
    bf16x8 Aw[2], Aa[2];
#pragma unroll
    for (int kk = 0; kk < 2; ++kk) { Aw[kk] = *(const LAS bf16x8*)(tw + fr * 72 + kk * 32 + fq * 8); Aa[kk] = *(const LAS bf16x8*)(ca + fr * 72 + kk * 32 + fq * 8); }
#pragma unroll 1
    for (int hi = 0; hi < 2; ++hi) {
        const int hh = wave + 8 * hi;
        float kkv[4][4], av[4][4], bop[4];
#pragma unroll
        for (int jj = 0; jj < 4; ++jj) bop[jj] = 0.f;
#pragma unroll
        for (int n = 0; n < 4; ++n) {
            const int c = hh * 64 + 16 * n + fr;
            f32x4 accw = {0.f, 0.f, 0.f, 0.f}, acca = {0.f, 0.f, 0.f, 0.f};
#pragma unroll
            for (int kk = 0; kk < 2; ++kk) { const bf16x8 Bw = *(const bf16x8*)(W.wupt + (size_t)c * 64 + kk * 32 + fq * 8), Ba = *(const bf16x8*)(W.aupt + (size_t)c * 64 + kk * 32 + fq * 8);
                accw = __builtin_amdgcn_mfma_f32_16x16x32_bf16(Aw[kk], Bw, accw, 0, 0, 0); acca = __builtin_amdgcn_mfma_f32_16x16x32_bf16(Aa[kk], Ba, acca, 0, 0, 0); }
            const float w0c = W.w0[c], a0c = W.a0[c], kkc = W.k_k[c], kac = W.k_a[c], rkc = W.r_k[c];
            const float mur = W.mu[c], muk = W.mu[1024 + c], muv = W.mu[2048 + c];
#pragma unroll
            for (int jj = 0; jj < 4; ++jj) {
                const int tt = 4 * fq + jj;
                const LAS unsigned short* x1 = X + (tt + 1) * 3200 + c; const LAS unsigned short* x0 = X + tt * 3200 + c;
                const float r1 = bf2f(x1[0]), k1 = bf2f(x1[1024]), v1 = bf2f(x1[2048]);
                const float cr = r1 + (bf2f(x0[0]) - r1) * mur, ck = k1 + (bf2f(x0[1024]) - k1) * muk, cv = v1 + (bf2f(x0[2048]) - v1) * muv;
                const float sig = 1.0f / (1.0f + __expf(-(w0c + accw[jj])));
                const float dec = __expf(-0.6065306597126334f * sig);
                const float a = 1.0f / (1.0f + __expf(-(a0c + acca[jj])));
                const float kp = ck * (1.0f + (a - 1.0f) * kac);
                kkv[n][jj] = ck * kkc; av[n][jj] = a; bop[jj] += cr * kp * rkc;
                const size_t o = (size_t)(t0 + tt) * DBR + c;
                decay[o] = dec; ok[o] = (bf16_t)f2bf(kp); orr[o] = (bf16_t)f2bf(cr); ov[o] = (bf16_t)f2bf(cv);
            }
        }
#pragma unroll
        for (int jj = 0; jj < 4; ++jj) {
            float ss = (kkv[0][jj] * kkv[0][jj] + kkv[1][jj] * kkv[1][jj]) + (kkv[2][jj] * kkv[2][jj] + kkv[3][jj] * kkv[3][jj]);
            ss = rowsum16(ss);
            const float rs = 1.0f / sqrtf(fmaxf(ss, 1e-24f));
            const float bo = rowsum16(bop[jj]);
            const int t = t0 + 4 * fq + jj;
#pragma unroll
            for (int n = 0; n < 4; ++n) { const size_t o = (size_t)t * DBR + hh * 64 + 16 * n + fr; const float kkn = kkv[n][jj] * rs;
                okk[o] = (bf16_t)f2bf(kkn); ob[o] = (bf16_t)f2bf(kkn * av[n][jj]); }
            if (fr == 0) bonus[(size_t)t * 16 + hh] = bo;
        }
    }
    __syncthreads();
}

struct RwStep { f32x4 w, kk, bb, kv, rr; };
__device__ __forceinline__ void rwkv_seq(LAS unsigned char* lds, const float* decay, const bf16_t* akk, const bf16_t* ab, const bf16_t* ak, const bf16_t* ar, const bf16_t* av, float* Yraw, int blk, int tid) {
    const int hh = blk >> 2, qv = blk & 3;
    const int wave = tid >> 6, lane = tid & 63;
    LAS float* tile = (LAS float*)lds;
    LAS float* vbuf = (LAS float*)(lds + 81920);
    LAS float* ypart = (LAS float*)(lds + 81920 + 4096);
    const bool loader = wave >= 4;
    const int lt = tid & 255;
    constexpr int NT = S_ / 32;
    f32x4 rw[2]; u32x2 rk[4][2]; unsigned rv[2];
    const size_t cbase = (size_t)hh * 64;
#define RW_ISSUE(n) do { _Pragma("unroll") for (int i_ = 0; i_ < 2; ++i_) { const int e_ = lt + 256 * i_, st_ = e_ >> 4, c4_ = e_ & 15; \
        const size_t gi_ = (size_t)((n) * 32 + st_) * DBR + cbase + c4_ * 4; \
        rw[i_] = *(const f32x4*)(decay + gi_); rk[0][i_] = *(const u32x2*)(akk + gi_); rk[1][i_] = *(const u32x2*)(ab + gi_); rk[2][i_] = *(const u32x2*)(ak + gi_); rk[3][i_] = *(const u32x2*)(ar + gi_); \
        rv[i_] = av[(size_t)((n) * 32 + st_) * DBR + cbase + qv * 16 + c4_]; } } while (0)
#define RW_WRITE(b) do { _Pragma("unroll") for (int i_ = 0; i_ < 2; ++i_) { const int e_ = lt + 256 * i_, st_ = e_ >> 4, c4_ = e_ & 15; \
        LAS float* d_ = tile + ((b) * 32 + st_) * 320 + c4_ * 4; *(LAS f32x4*)d_ = rw[i_]; \
        _Pragma("unroll") for (int a_ = 0; a_ < 4; ++a_) { f32x4 f_; f_[0] = bflo(rk[a_][i_].x); f_[1] = bfhi(rk[a_][i_].x); f_[2] = bflo(rk[a_][i_].y); f_[3] = bfhi(rk[a_][i_].y); *(LAS f32x4*)(d_ + 64 * (a_ + 1)) = f_; } \
        vbuf[((b) * 16 + c4_) * 32 + st_] = bf2f(rv[i_]); } } while (0)
#define RW_FLUSH(n, b) do { _Pragma("unroll") for (int i_ = 0; i_ < 2; ++i_) { const int e_ = lt + 256 * i_, st_ = e_ >> 4, r_ = e_ & 15; \
        const LAS f32x4* yp_ = (const LAS f32x4*)(ypart + (((b) * 32 + st_) * 16 + r_) * 8); const f32x4 a_ = yp_[0], c_ = yp_[1]; \
        Yraw[(size_t)((n) * 32 + st_) * DBR + cbase + qv * 16 + r_] = ((a_[0] + a_[1]) + (a_[2] + a_[3])) + ((c_[0] + c_[1]) + (c_[2] + c_[3])); } } while (0)
    if (loader) { RW_ISSUE(0); RW_WRITE(0); }
    __syncthreads();
    const int row_l = (wave & 3) * 4 + (lane >> 4), ks = lane & 15;
    f32x2 s01 = {0.f, 0.f}, s23 = {0.f, 0.f};
#define RW_LD(dst, st_) do { const LAS float* bs_ = tb + (st_) * 320; dst.w = *(const LAS f32x4*)bs_; dst.kk = *(const LAS f32x4*)(bs_ + 64); dst.bb = *(const LAS f32x4*)(bs_ + 128); \
        dst.kv = *(const LAS f32x4*)(bs_ + 192); dst.rr = *(const LAS f32x4*)(bs_ + 256); } while (0)
#define RW_STEP(src, st_) do { const f32x2 t_ = s01 * (f32x2){src.kk[0], src.kk[1]} + s23 * (f32x2){src.kk[2], src.kk[3]}; \
        const float sa_ = -rowsum16(t_[0] + t_[1]); const float vr_ = vq[(st_) >> 2][(st_) & 3]; \
        s01 = s01 * (f32x2){src.w[0], src.w[1]} + sa_ * (f32x2){src.bb[0], src.bb[1]} + vr_ * (f32x2){src.kv[0], src.kv[1]}; \
        s23 = s23 * (f32x2){src.w[2], src.w[3]} + sa_ * (f32x2){src.bb[2], src.bb[3]} + vr_ * (f32x2){src.kv[2], src.kv[3]}; \
        const f32x2 yv_ = s01 * (f32x2){src.rr[0], src.rr[1]} + s23 * (f32x2){src.rr[2], src.rr[3]}; \
        float y_ = yv_[0] + yv_[1]; y_ += dppf<0xB1>(y_); \
        yb[(st_) * 128] = y_; } while (0)
    for (int n = 0; n < NT; ++n) {
        const int b = n & 1;
        if (loader) {
            if (n + 1 < NT) RW_ISSUE(n + 1);
            if (n > 0) RW_FLUSH(n - 1, b ^ 1);
            if (n + 1 < NT) RW_WRITE(b ^ 1);
        } else {
            RwStep ca, cb;
            const LAS float* tb = tile + b * (32 * 320) + 4 * ks;
            LAS float* yb = ypart + (b * 512 + row_l) * 8 + (ks >> 1);
            f32x4 vq[8];
            RW_LD(ca, 0);
            __builtin_amdgcn_sched_barrier(0);
            { const LAS f32x4* vb = (const LAS f32x4*)(vbuf + (b * 16 + row_l) * 32);
#pragma unroll
              for (int q = 0; q < 8; ++q) vq[q] = vb[q]; }
            __builtin_amdgcn_sched_barrier(0);
#pragma unroll
            for (int st = 0; st < 32; st += 2) {
                RW_LD(cb, st + 1);
                RW_STEP(ca, st);
                if (st + 2 < 32) RW_LD(ca, st + 2);
                RW_STEP(cb, st + 1);
            }
        }
        __syncthreads();
    }
    if (loader) RW_FLUSH(NT - 1, (NT - 1) & 1);
    __syncthreads();
#undef RW_ISSUE
#undef RW_WRITE
#undef RW_FLUSH
#undef RW_LD
#undef RW_STEP
}

struct LruW { const float *conv_w, *conv_b, *gate_b, *lam; const bf16_t* wgt; };
__device__ __forceinline__ void lru_chunk_unit(LAS unsigned char* lds, const bf16_t* P, const LruW& W, bf16_t* HL, bf16_t* ACUM, float* AGA, float* AGB, int unit, int tid) {
    const int h = unit & 15, ci = unit >> 4, t0 = ci * 64;
    const int wave = tid >> 6, lane = tid & 63;
    LAS float* xcf = (LAS float*)lds;
    LAS float* As = xcf + 4096;
    LAS float* Bs = As + 4096;
    LAS float* SA = Bs + 4096;
    LAS float* SB = SA + 512;
    LAS unsigned short* xcb = (LAS unsigned short*)(SB + 512 + 64);
    const int c = tid & 63, tg = tid >> 6;
    const int ch = h * 64 + c;
    const float cw0 = W.conv_w[0 * DBR + ch], cw1 = W.conv_w[1 * DBR + ch], cw2 = W.conv_w[2 * DBR + ch], cw3 = W.conv_w[3 * DBR + ch], cb = W.conv_b[ch];
    float xa[11];
#pragma unroll
    for (int i = 0; i < 11; ++i) { const int t = t0 + tg * 8 + i - 3; xa[i] = (t >= 0) ? bf2f(P[(size_t)t * NP + COL_XA + ch]) : 0.f; }
    const int tb = wave & 3, chh = wave >> 2, fr = lane & 15, fq = lane >> 4;
    bf16x8 Bf[2][2][2];
    float gb0[2], gb1[2], sp[2];
#pragma unroll
    for (int n = 0; n < 2; ++n) { const int j = 32 * chh + 16 * n + fr;
        gb0[n] = W.gate_b[h * 64 + j]; gb1[n] = W.gate_b[DBR + h * 64 + j]; sp[n] = softplusf_(-W.lam[h * 64 + j]);
#pragma unroll
        for (int g = 0; g < 2; ++g)
#pragma unroll
            for (int kk = 0; kk < 2; ++kk) Bf[g][n][kk] = *(const bf16x8*)(W.wgt + ((size_t)((g * 16 + h) * 64 + j)) * 64 + kk * 32 + fq * 8); }
#pragma unroll
    for (int tt = 0; tt < 8; ++tt) {
        const float xc = cb + cw0 * xa[tt] + cw1 * xa[tt + 1] + cw2 * xa[tt + 2] + cw3 * xa[tt + 3];
        xcf[(tg * 8 + tt) * 64 + c] = xc; xcb[(tg * 8 + tt) * 72 + c] = (unsigned short)f2bf(xc);
    }
    __syncthreads();
    {
        bf16x8 Af[2];
#pragma unroll
        for (int kk = 0; kk < 2; ++kk) Af[kk] = *(const LAS bf16x8*)(xcb + (tb * 16 + fr) * 72 + kk * 32 + fq * 8);
        f32x4 acc[2][2];
#pragma unroll
        for (int g = 0; g < 2; ++g)
#pragma unroll
            for (int n = 0; n < 2; ++n) { acc[g][n] = (f32x4){0.f, 0.f, 0.f, 0.f};
#pragma unroll
                for (int kk = 0; kk < 2; ++kk) acc[g][n] = __builtin_amdgcn_mfma_f32_16x16x32_bf16(Af[kk], Bf[g][n][kk], acc[g][n], 0, 0, 0); }
#pragma unroll
        for (int n = 0; n < 2; ++n)
#pragma unroll
            for (int jj = 0; jj < 4; ++jj) {
                const int tl = tb * 16 + 4 * fq + jj, cc = 32 * chh + 16 * n + fr;
                const float r = 1.0f / (1.0f + __expf(-(acc[0][n][jj] + gb0[n])));
                const float ig = 1.0f / (1.0f + __expf(-(acc[1][n][jj] + gb1[n])));
                const float la = -8.0f * r * sp[n];
                const float a = expf(la);
                float mult = sqrtf(-expm1f(2.0f * la));
                if (t0 + tl == 0) mult = 1.0f;
                As[tl * 64 + cc] = a; Bs[tl * 64 + cc] = mult * ig * xcf[tl * 64 + cc];
            }
    }
    __syncthreads();
    float hl[8], ac[8];
    {
        float hrun = 0.f, arun = 1.f;
#pragma unroll
        for (int tt = 0; tt < 8; ++tt) { const float a = As[(tg * 8 + tt) * 64 + c], b = Bs[(tg * 8 + tt) * 64 + c]; hrun = a * hrun + b; arun *= a; hl[tt] = hrun; ac[tt] = arun; }
        SA[tg * 64 + c] = arun; SB[tg * 64 + c] = hrun;
    }
    __syncthreads();
    float hin = 0.f, cin = 1.f;
    for (int s = 0; s < tg; ++s) { const float sa = SA[s * 64 + c]; hin = sa * hin + SB[s * 64 + c]; cin *= sa; }
#pragma unroll
    for (int tt = 0; tt < 8; ++tt) { const float hv = hl[tt] + ac[tt] * hin, av = ac[tt] * cin; const size_t o = (size_t)(t0 + tg * 8 + tt) * DBR + ch;
        HL[o] = (bf16_t)f2bf(hv); ACUM[o] = (bf16_t)f2bf(av);
        if (tt == 7 && tg == 7) { AGA[(size_t)ci * DBR + ch] = av; AGB[(size_t)ci * DBR + ch] = hv; } }
    __syncthreads();
}

constexpr int AT_KROW = 136 * 2;
constexpr int AT_VROW = 68 * 2;
constexpr int AT_KBYTES = 64 * AT_KROW;
constexpr int AT_VBYTES = 128 * AT_VROW;
constexpr int AT_BUF = AT_KBYTES + AT_VBYTES + 256;
__device__ __forceinline__ void attn_unit(LAS unsigned char* lds, const bf16_t* P, const bf16_t* Vt, const float* C, const float* TS, const unsigned* KN, bf16_t* Yb, int h, int qb, int tid) {
    const int wave = tid >> 6, lane = tid & 63, ql = lane & 31, hf = lane >> 5;
    LAS float* offs = (LAS float*)(lds + 2 * AT_BUF);
    LAS float* needw = offs + 256;
    if (tid < 64) { const f32x4 v = *(const f32x4*)(TS + h * 256 + 4 * tid); float x = (v[0] + v[1]) + (v[2] + v[3]);
#pragma unroll
        for (int o = 1; o < 64; o <<= 1) { const float y = __shfl_up(x, o); if (tid >= o) x += y; }
        const float e0 = x - ((v[0] + v[1]) + (v[2] + v[3]));
        *(LAS f32x4*)(offs + 4 * tid) = (f32x4){e0, e0 + v[0], e0 + v[0] + v[1], e0 + v[0] + v[1] + v[2]}; }
    __syncthreads();
    const int qw0 = qb * 256 + wave * 32, q = qw0 + ql;
    bf16x8 Qf[8];
    { const bf16_t* qp = P + (size_t)q * NP + COL_Q + h * 128 + 8 * hf;
#pragma unroll
      for (int ks = 0; ks < 8; ++ks) Qf[ks] = *(const bf16x8*)(qp + 16 * ks); }
    const float cq = (offs[q >> 6] + C[(size_t)h * S_ + q]) * LOG2E;
    const float SC = 0.08838834764831845f * LOG2E;
    float qss = 0.f;
#pragma unroll
    for (int ks = 0; ks < 8; ++ks)
#pragma unroll
        for (int e = 0; e < 8; ++e) { const float v = bf2f((unsigned)(unsigned short)Qf[ks][e]); qss += v * v; }
    qss += __shfl_xor(qss, 32);
    const float needc = sqrtf(qss) * sqrtf(__uint_as_float(KN[h])) * SC * 1.001f + cq + 40.0f;
    f32x16 O[4];
#pragma unroll
    for (int db = 0; db < 4; ++db)
#pragma unroll
        for (int i = 0; i < 16; ++i) O[db][i] = 0.f;
    float m = -INFINITY, l = 0.f;
    const int ntile = 4 * qb + 4;
    u32x4 kreg[2], vreg[2]; float ckreg = 0.f;
    const bf16_t* kbase = P + COL_K + h * 128;
    const bf16_t* vbase = Vt + (size_t)h * 128 * S_;
    const float* cbase = C + (size_t)h * S_;
#define AT_LOAD(kt_) do { const int k0_ = (kt_) * 64; _Pragma("unroll") for (int i_ = 0; i_ < 2; ++i_) { const int id_ = tid + 512 * i_; \
        kreg[i_] = *(const u32x4*)(kbase + (size_t)(k0_ + (id_ >> 4)) * NP + (id_ & 15) * 8); \
        vreg[i_] = *(const u32x4*)(vbase + (size_t)(id_ >> 3) * S_ + k0_ + (id_ & 7) * 8); } \
        if (tid < 64) ckreg = (offs[(kt_)] + cbase[k0_ + tid]) * LOG2E; } while (0)
#define AT_WRITE(b_) do { LAS unsigned char* bb_ = lds + (b_) * AT_BUF; _Pragma("unroll") for (int i_ = 0; i_ < 2; ++i_) { const int id_ = tid + 512 * i_; \
        *(LAS u32x4*)(bb_ + (id_ >> 4) * AT_KROW + (id_ & 15) * 16) = kreg[i_]; \
        LAS u32x2* vd_ = (LAS u32x2*)(bb_ + AT_KBYTES + (id_ >> 3) * AT_VROW + (id_ & 7) * 16); vd_[0] = (u32x2){vreg[i_].x, vreg[i_].y}; vd_[1] = (u32x2){vreg[i_].z, vreg[i_].w}; } \
        if (tid < 64) *(LAS float*)(bb_ + AT_KBYTES + AT_VBYTES + tid * 4) = ckreg; } while (0)
    AT_LOAD(ntile - 1); AT_WRITE(0);
    if (tid < 16) needw[tid] = INFINITY;
    __syncthreads();
    for (int it = 0; it < ntile; ++it) {
        const int kt = ntile - 1 - it, b = it & 1;
        bool more = (kt > 0);
        if (more) {
            const LAS float* nw = needw + ((it & 1) ^ 1) * 8;
            const f32x4 n0 = *(const LAS f32x4*)nw, n1 = *(const LAS f32x4*)(nw + 4);
            const float need = fmaxf(fmaxf(fmaxf(n0[0], n0[1]), fmaxf(n0[2], n0[3])), fmaxf(fmaxf(n1[0], n1[1]), fmaxf(n1[2], n1[3])));
            more = !(need <= offs[kt] * LOG2E);
        }
        if (more) AT_LOAD(kt - 1);
        const int k0 = kt * 64;
        float nd = INFINITY;
        if (k0 <= qw0 + 31) {
            const LAS unsigned char* Kl = lds + b * AT_BUF;
            const LAS unsigned char* Vl = Kl + AT_KBYTES;
            const LAS float* ckl = (const LAS float*)(Vl + AT_VBYTES);
            f32x16 Sx[2];
#pragma unroll
            for (int kb = 0; kb < 2; ++kb) {
#pragma unroll
                for (int i = 0; i < 16; ++i) Sx[kb][i] = 0.f;
#pragma unroll
                for (int ks = 0; ks < 8; ++ks) { const bf16x8 A = *(const LAS bf16x8*)(Kl + (kb * 32 + ql) * AT_KROW + (16 * ks + 8 * hf) * 2);
                    Sx[kb] = __builtin_amdgcn_mfma_f32_32x32x16_bf16(A, Qf[ks], Sx[kb], 0, 0, 0); }
            }
            const bool diag = (k0 + 63 > qw0);
            float mx = m;
#pragma unroll
            for (int kb = 0; kb < 2; ++kb)
#pragma unroll
                for (int i4 = 0; i4 < 4; ++i4) { const f32x4 ckv = *(const LAS f32x4*)(ckl + 32 * kb + 8 * i4 + 4 * hf);
#pragma unroll
                    for (int j = 0; j < 4; ++j) { const int i = 4 * i4 + j; float s = Sx[kb][i] * SC + (cq - ckv[j]);
                        if (diag) { const int key = k0 + 32 * kb + 8 * i4 + 4 * hf + j; if (key > q) s = -INFINITY; }
                        Sx[kb][i] = s; mx = fmaxf(mx, s); } }
            mx = fmaxf(mx, __shfl_xor(mx, 32));
            const float alpha = __builtin_amdgcn_exp2f(m - mx);
            m = mx; l *= alpha;
#pragma unroll
            for (int kb = 0; kb < 2; ++kb)
#pragma unroll
                for (int i = 0; i < 16; ++i) { const float p = __builtin_amdgcn_exp2f(Sx[kb][i] - mx); Sx[kb][i] = p; l += p; }
#pragma unroll
            for (int db = 0; db < 4; ++db)
#pragma unroll
                for (int i = 0; i < 16; ++i) O[db][i] *= alpha;
            bf16x8 Pf[4];
#pragma unroll
            for (int s = 0; s < 4; ++s) { const int kb = s >> 1, i0 = 8 * (s & 1);
                u32x4 w; w.x = cvt_pk_bf16(Sx[kb][i0 + 0], Sx[kb][i0 + 1]); w.y = cvt_pk_bf16(Sx[kb][i0 + 2], Sx[kb][i0 + 3]); w.z = cvt_pk_bf16(Sx[kb][i0 + 4], Sx[kb][i0 + 5]); w.w = cvt_pk_bf16(Sx[kb][i0 + 6], Sx[kb][i0 + 7]);
                Pf[s] = __builtin_bit_cast(bf16x8, w); }
#pragma unroll
            for (int db = 0; db < 4; ++db)
#pragma unroll
                for (int s = 0; s < 4; ++s) { const LAS unsigned char* vp = Vl + (32 * db + ql) * AT_VROW + (16 * s + 4 * hf) * 2;
                    const u32x2 lo = *(const LAS u32x2*)vp, hi = *(const LAS u32x2*)(vp + 16);
                    const u32x4 a4 = {lo.x, lo.y, hi.x, hi.y};
                    O[db] = __builtin_amdgcn_mfma_f32_32x32x16_bf16(__builtin_bit_cast(bf16x8, a4), Pf[s], O[db], 0, 0, 0); }
            nd = needc - m;
            nd = fmaxf(nd, dppf<0xB1>(nd)); nd = fmaxf(nd, dppf<0x4E>(nd)); nd = fmaxf(nd, dppf<0x141>(nd)); nd = fmaxf(nd, dppf<0x140>(nd));
            nd = fmaxf(nd, __shfl_xor(nd, 16)); nd = fmaxf(nd, __shfl_xor(nd, 32));
        }
        if (lane == 0) needw[(it & 1) * 8 + wave] = nd;
        if (more) AT_WRITE(b ^ 1);
        __syncthreads();
        if (!more) break;
    }
    l += __shfl_xor(l, 32);
    const float inv = 1.0f / l;
#pragma unroll
    for (int db = 0; db < 4; ++db)
#pragma unroll
        for (int i4 = 0; i4 < 4; ++i4) { const int d = 32 * db + 8 * i4 + 4 * hf;
            const u32x2 g = *(const u32x2*)(P + (size_t)q * NP + COL_GB + h * 128 + d);
            const float o0 = O[db][4 * i4 + 0] * inv * siluf_(bflo(g.x)), o1 = O[db][4 * i4 + 1] * inv * siluf_(bfhi(g.x));
            const float o2 = O[db][4 * i4 + 2] * inv * siluf_(bflo(g.y)), o3 = O[db][4 * i4 + 3] * inv * siluf_(bfhi(g.y));
            u32x2 w; w.x = cvt_pk_bf16(o0, o1); w.y = cvt_pk_bf16(o2, o3);
            *(u32x2*)(Yb + (size_t)q * DBR + h * 128 + d) = w; }
#undef AT_LOAD
#undef AT_WRITE
}

#ifndef P4S
#define P4SEL(n) 1
#else
#define P4SEL(n) (P4S == (n))
#endif
#ifndef PH
#define PHSEL(n) 1
#else
#define PHSEL(n) ((PH) >= 100 ? ((n) != (PH) - 100) : (PH) == (n))
#endif
#ifndef REPRW
#define REPRW 1
#endif
#ifndef REP2
#define REP2 1
#endif
#ifndef REP3
#define REP3 1
#endif
#ifndef REP4
#define REP4 1
#endif
#ifndef REP5
#define REP5 1
#endif
typedef __attribute__((address_space(4))) const Params* KP;
#define KP_FRESH(kp) KP kp = (KP)__builtin_amdgcn_kernarg_segment_ptr(); asm volatile("" : "+s"(kp))

__global__ void __launch_bounds__(512) hybrid_fwd(Params p_unused) {
    extern __shared__ __attribute__((aligned(16))) unsigned char lds_raw[];
    LAS unsigned char* lds = (LAS unsigned char*)lds_raw;
    cg::grid_group grid = cg::this_grid();
    const int G = gridDim.x, bid = blockIdx.x, NGW = G * 8;
    if (threadIdx.x < 2) ((volatile LAS unsigned*)(lds + XB_ST_OFF))[threadIdx.x] = 0u;
    { KP_FRESH(kpb); unsigned* ctl0 = (unsigned*)(kpb->ws + OFF_CTL);
      for (int w = bid * 512 + (int)threadIdx.x; w < CW_XBAR + XCD_BAR_WORDS; w += G * 512) ctl0[w] = 0u; }
    __syncthreads();
#define GRID_BAR() do { KP_FRESH(kpb_); XcdBarrier b_; b_.bar = (unsigned*)(kpb_->ws + OFF_CTL) + CW_XBAR; b_.x = xb_xcc_id(); b_.st = (volatile LAS unsigned*)(lds + XB_ST_OFF); xcd_barrier(b_); } while (0)
#define TID_FRESH() const int tid = fresh_tid(), lane = tid & 63, wave = __builtin_amdgcn_readfirstlane(tid >> 6), gw = bid * 8 + wave; (void)lane; (void)gw

#if PHSEL(0)
    {
        KP_FRESH(kp); TID_FRESH();
        unsigned char* ws = kp->ws;
        LAS float* scr = (LAS float*)(lds + wave * 16384);
        convert_win(kp->in[3], (bf16_t*)(ws + OFF_WIN), scr, gw, NGW, lane);
#pragma unroll 1
        for (int l = 0; l < 2; ++l) {
            bf16_t* WBR = (bf16_t*)(ws + OFF_WSM + l * SZ_WSM_L); bf16_t* WOUT = (bf16_t*)((unsigned char*)WBR + SZ_WBR); bf16_t* WGT = (bf16_t*)((unsigned char*)WOUT + SZ_WOUT);
#pragma unroll 1
            for (int z = 0; z < 3; ++z) { const float* src = kp->in[21] + (size_t)(l * 3 + z) * DBR * DM;
                for (int it = gw; it < (DBR / 64) * (DM / 32); it += NGW) transpose_item<false>(src, DBR, DM, WBR + (size_t)z * DM * DBR, scr, it, DM / 32, lane); }
            { const float* src = kp->in[22] + (size_t)l * DM * DM;
                for (int it = gw; it < (DM / 64) * (DM / 32); it += NGW) transpose_item<false>(src, DM, DM, WOUT, scr, it, DM / 32, lane); }
            { bf16_t* WL = (bf16_t*)((unsigned char*)WGT + SZ_WGT); const float* wu = kp->in[13] + (size_t)l * 64 * DBR; const float* au = kp->in[15] + (size_t)l * 64 * DBR;
                for (int e = bid * 512 + tid; e < DBR * 64; e += G * 512) { const int k = e & 63, c = e >> 6; WL[e] = (bf16_t)f2bf(wu[(size_t)k * DBR + c]); WL[(size_t)DBR * 64 + e] = (bf16_t)f2bf(au[(size_t)k * DBR + c]); } }
            { const float* src = kp->in[7] + (size_t)l * 2 * 16 * 64 * 64;
                for (int e = bid * 512 + tid; e < 2 * 16 * 64 * 64; e += G * 512) { const int i = e & 63, j = (e >> 6) & 63, gh = e >> 12; WGT[e] = (bf16_t)f2bf(src[(size_t)gh * 4096 + i * 64 + j]); } }
        }
        const float* x = kp->in[0]; const float* pre = kp->in[1]; bf16_t* H = (bf16_t*)(ws + OFF_HY);
        f32x4 gv0[8];
#pragma unroll
        for (int j = 0; j < 8; ++j) gv0[j] = *((const f32x4*)pre + lane + 64 * j);
#pragma unroll 2
        for (int row = gw; row < S_; row += NGW) {
            const f32x4* xr = (const f32x4*)(x + (size_t)row * DM) + lane; f32x4 v[8]; float s = 0.f;
#pragma unroll
            for (int j = 0; j < 8; ++j) { v[j] = xr[64 * j]; s += (v[j][0] * v[j][0] + v[j][1] * v[j][1]) + (v[j][2] * v[j][2] + v[j][3] * v[j][3]); }
            rms_row_store_g(v, wave_sum(s), gv0, H + (size_t)row * DM, lane);
        }
    }
#endif
    grid.sync();
    { KP_FRESH(kpb); if (threadIdx.x == 0) (void)xb_add((unsigned*)(kpb->ws + OFF_CTL) + CW_XBAR + XB_XCNT(xb_xcc_id()), 1u); }

#pragma unroll 1
    for (int l = 0; l < 2; ++l) {
        { KP_FRESH(kp); TID_FRESH(); unsigned char* ws = kp->ws;
          pg8::Gemm g{(const bf16_t*)(ws + OFF_HY), (const bf16_t*)(ws + OFF_WIN), S_, NA, DM, 0, 0}; pg8::StaticOrder so; so.init(S_, NA, G, bid, 1);
          pg8::EpiStore E{(bf16_t*)(ws + OFF_P), NP};
          pg8::gemm_phase<pg8::EpiStore>(lds, g, so, E); }
        {
            const int nfill_blk = G - ((S_ / 256) * (NA / 256)) % G;
            const int first = G - nfill_blk;
            KP_FRESH(kp); TID_FRESH(); unsigned char* ws = kp->ws;
            if (bid >= first) {
                pg8::Gemm g{(const bf16_t*)(ws + OFF_HY), (const bf16_t*)(ws + OFF_WIN) + (size_t)(NP - NFILL) * DM, S_, NFILL, DM, 0, 0}; pg8::StaticOrder so; so.init(S_, NFILL, nfill_blk, bid - first, 1);
                pg8::EpiStoreGate E{(bf16_t*)(ws + OFF_P) + (NP - NFILL), NP, 0, kp->in[4] + (size_t)l * 3 * DM + (NP - NFILL - COL_MG)};
                pg8::gemm_phase<pg8::EpiStoreGate>(lds, g, so, E);
            }
        }
        GRID_BAR();
        {
            KP_FRESH(kp); TID_FRESH(); unsigned char* ws = kp->ws;
            const bf16_t* P = (const bf16_t*)(ws + OFF_P);
            const bf16_t* wlora = (const bf16_t*)(ws + OFF_WSM + l * SZ_WSM_L + SZ_WBR + SZ_WOUT + SZ_WGT);
            RwkvW rw{kp->in[11] + (size_t)l * 3200, kp->in[12] + (size_t)l * DBR, kp->in[14] + (size_t)l * DBR, kp->in[16] + (size_t)l * DBR, kp->in[17] + (size_t)l * DBR, kp->in[18] + (size_t)l * DBR, wlora, wlora + (size_t)DBR * 64};
            float* DEC = (float*)(ws + OFF_RW); bf16_t* RKK = (bf16_t*)(ws + OFF_RW + SZ_DEC);
            for (int u = bid; u < S_ / 16; u += G)
                rwkv_prep_unit(lds, P, rw, DEC, RKK, RKK + (size_t)S_ * DBR, RKK + (size_t)2 * S_ * DBR, RKK + (size_t)3 * S_ * DBR, RKK + (size_t)4 * S_ * DBR, (float*)(ws + OFF_BON), u, tid);
        }
        GRID_BAR();
        {
            const unsigned GB = (unsigned)(G - N_RWKV_BLK);
            if (bid < N_RWKV_BLK) {
                { KP_FRESH(kp); TID_FRESH(); unsigned char* ws = kp->ws;
                  const bf16_t* RKK = (const bf16_t*)(ws + OFF_RW + SZ_DEC);
                  for (int rr_ = 0; rr_ < REPRW; ++rr_) rwkv_seq(lds, (const float*)(ws + OFF_RW), RKK, RKK + (size_t)S_ * DBR, RKK + (size_t)2 * S_ * DBR, RKK + (size_t)3 * S_ * DBR, RKK + (size_t)4 * S_ * DBR, (float*)(ws + OFF_YRAW), bid, tid); }
                { KP_FRESH(kp); part_wait((unsigned*)(kp->ws + OFF_CTL) + CW_PB + 64 * l, 2 * GB); }
            } else {
                { KP_FRESH(kp); TID_FRESH(); unsigned char* ws = kp->ws;
                  pg8::Gemm g{(const bf16_t*)(ws + OFF_HY), (const bf16_t*)(ws + OFF_WIN) + (size_t)NA * DM, S_, NP - NA - NFILL, DM, 0, 0}; pg8::StaticOrder so; so.init(S_, NP - NA - NFILL, (int)GB, bid - N_RWKV_BLK, 1);
                  pg8::EpiStoreGate E{(bf16_t*)(ws + OFF_P) + NA, NP, (COL_MG - NA) / 256, kp->in[4] + (size_t)l * 3 * DM};
                  pg8::gemm_phase<pg8::EpiStoreGate>(lds, g, so, E); }
                { KP_FRESH(kp); part_barrier((unsigned*)(kp->ws + OFF_CTL) + CW_PB + 64 * l, GB); }
                { KP_FRESH(kp); TID_FRESH(); unsigned char* ws = kp->ws;
                  const bf16_t* P = (const bf16_t*)(ws + OFF_P);
                  constexpr int NU_VT = (S_ / 64) * 8, NU_LRU = 16 * (S_ / 64);
                  LruW lw{kp->in[5] + (size_t)l * 4 * DBR, kp->in[6] + (size_t)l * DBR, kp->in[8] + (size_t)l * 2 * DBR, kp->in[9] + (size_t)l * DBR, (const bf16_t*)(ws + OFF_WSM + l * SZ_WSM_L + SZ_WBR + SZ_WOUT)};
                  for (int u = bid - N_RWKV_BLK; u < NU_VT + NU_LRU; u += (int)GB) {
                      if (u >= NU_VT) lru_chunk_unit(lds, P, lw, (bf16_t*)(ws + OFF_HY), (bf16_t*)(ws + OFF_ACUM), (float*)(ws + OFF_AGA), (float*)(ws + OFF_AGB), u - NU_VT, tid);
                      else vt_unit(lds, P, (bf16_t*)(ws + OFF_VT), kp->in[10] + l * 8, (float*)(ws + OFF_C), (float*)(ws + OFF_TS), (unsigned*)(ws + OFF_CTL) + CW_KN + 64 * l, u, tid);
                  } }
                { KP_FRESH(kp); part_barrier((unsigned*)(kp->ws + OFF_CTL) + CW_PB + 64 * l, 2 * GB); }
                if (bid == N_RWKV_BLK) { KP_FRESH(kp); TID_FRESH(); unsigned char* ws = kp->ws;
                    const float* AGA = (const float*)(ws + OFF_AGA); const float* AGB = (const float*)(ws + OFF_AGB); float* CIN = (float*)(ws + OFF_CIN);
#pragma unroll
                    for (int cc = 0; cc < 2; ++cc) { const int c = tid + 512 * cc; float carry = 0.f;
#pragma unroll 8
                        for (int ci = 0; ci < S_ / 64; ++ci) { CIN[(size_t)ci * DBR + c] = carry; carry = AGA[(size_t)ci * DBR + c] * carry + AGB[(size_t)ci * DBR + c]; } }
                }
            }
            { KP_FRESH(kp); TID_FRESH(); unsigned char* ws = kp->ws;
            LAS int* sh = (LAS int*)(lds + 144 * 1024 - 64);
            unsigned* ctr = (unsigned*)(ws + OFF_CTL) + CW_ATTN + 64 * l;
            for (;;) {
                __syncthreads();
                if (tid == 0) *sh = (int)atomicAdd(ctr, 1u);
                __syncthreads();
                const int u = *sh;
                if (u >= 512) break;
                attn_unit(lds, (const bf16_t*)(ws + OFF_P), (const bf16_t*)(ws + OFF_VT), (const float*)(ws + OFF_C), (const float*)(ws + OFF_TS), (const unsigned*)(ws + OFF_CTL) + CW_KN + 64 * l, (bf16_t*)(ws + OFF_HY) + (size_t)S_ * DBR, u & 7, 63 - (u >> 3), tid);
            } }
        }
        GRID_BAR();
#if PHSEL(5)
        {
            KP_FRESH(kp); TID_FRESH(); unsigned char* ws = kp->ws;
            bf16_t* Yc = (bf16_t*)(ws + OFF_HY) + (size_t)2 * S_ * DBR; bf16_t* Ya = (bf16_t*)(ws + OFF_HY);
            const bf16_t* ACUM = (const bf16_t*)(ws + OFF_ACUM); const float* CIN = (const float*)(ws + OFF_CIN);
            const float* YRAW = (const float*)(ws + OFF_YRAW); const float* BON = (const float*)(ws + OFF_BON);
            const bf16_t* RV = (const bf16_t*)(ws + OFF_RW + SZ_DEC) + (size_t)4 * S_ * DBR; const bf16_t* P = (const bf16_t*)(ws + OFF_P);
            const int q4 = (tid & 255) * 4, hh = q4 >> 6;
            const f32x4 lnw = *(const f32x4*)(kp->in[19] + (size_t)l * DBR + q4), lnb = *(const f32x4*)(kp->in[20] + (size_t)l * DBR + q4);
#pragma unroll 8
            for (int t = bid * 2 + (tid >> 8); t < S_; t += 2 * G) {
                const size_t o = (size_t)t * DBR + q4;
                const f32x4 y = *(const f32x4*)(YRAW + o);
                const u32x2 rv = *(const u32x2*)(RV + o), gc = *(const u32x2*)(P + (size_t)t * NP + COL_GC + q4), ga = *(const u32x2*)(P + (size_t)t * NP + COL_GA + q4);
                const u32x2 hl = *(const u32x2*)(Ya + o), ac = *(const u32x2*)(ACUM + o);
                const f32x4 cin = *(const f32x4*)(CIN + (size_t)(t >> 6) * DBR + q4);
                const float bon = BON[(size_t)t * 16 + hh];
                const float mu = rowsum16((y[0] + y[1]) + (y[2] + y[3])) * (1.0f / 64.0f);
                const f32x4 d = y - mu;
                const float var = rowsum16((d[0] * d[0] + d[1] * d[1]) + (d[2] * d[2] + d[3] * d[3])) * (1.0f / 64.0f);
                const float rs = 1.0f / sqrtf(var + GN_EPS);
                const float y0 = (d[0] * rs * lnw[0] + lnb[0] + bon * bflo(rv.x)) * siluf_(bflo(gc.x)), y1 = (d[1] * rs * lnw[1] + lnb[1] + bon * bfhi(rv.x)) * siluf_(bfhi(gc.x));
                const float y2 = (d[2] * rs * lnw[2] + lnb[2] + bon * bflo(rv.y)) * siluf_(bflo(gc.y)), y3 = (d[3] * rs * lnw[3] + lnb[3] + bon * bfhi(rv.y)) * siluf_(bfhi(gc.y));
                u32x2 w; w.x = cvt_pk_bf16(y0, y1); w.y = cvt_pk_bf16(y2, y3);
                *(u32x2*)(Yc + o) = w;
                const float h0 = (bflo(hl.x) + bflo(ac.x) * cin[0]) * siluf_(bflo(ga.x)), h1 = (bfhi(hl.x) + bfhi(ac.x) * cin[1]) * siluf_(bfhi(ga.x));
                const float h2 = (bflo(hl.y) + bflo(ac.y) * cin[2]) * siluf_(bflo(ga.y)), h3 = (bfhi(hl.y) + bfhi(ac.y) * cin[3]) * siluf_(bfhi(ga.y));
                u32x2 w2; w2.x = cvt_pk_bf16(h0, h1); w2.y = cvt_pk_bf16(h2, h3);
                *(u32x2*)(Ya + o) = w2;
            }
        }
#endif
        GRID_BAR();
#if PHSEL(6)
        for (int rep = 0; rep < REP5; ++rep) { if (rep) GRID_BAR(); KP_FRESH(kp); TID_FRESH(); unsigned char* ws = kp->ws;
          pg8::Gemm g{(const bf16_t*)(ws + OFF_HY), (const bf16_t*)(ws + OFF_WSM + l * SZ_WSM_L), S_, DM, DBR, (size_t)S_ * DBR * 2, (size_t)DM * DBR * 2}; pg8::StaticOrder so; so.init(S_, DM, G, bid, 3);
          pg8::EpiMerge E{(bf16_t*)(ws + OFF_M), (const bf16_t*)(ws + OFF_P)};
          pg8::gemm_phase<pg8::EpiMerge, true>(lds, g, so, E); }
#endif
        GRID_BAR();
#if PHSEL(7)
        { KP_FRESH(kp); TID_FRESH(); unsigned char* ws = kp->ws;
          pg8::Gemm g{(const bf16_t*)(ws + OFF_M), (const bf16_t*)(ws + OFF_WSM + l * SZ_WSM_L + SZ_WBR), S_, DM, DM, 0, 0}; pg8::StaticOrder so; so.init(S_, DM, G, bid, 1);
          pg8::EpiOut E{(bf16_t*)(ws + OFF_MO), (float*)(ws + OFF_CTL) + CW_ROWSS + l * S_};
          pg8::gemm_phase<pg8::EpiOut>(lds, g, so, E); }
#endif
        GRID_BAR();
#if PHSEL(8)
        {
            KP_FRESH(kp); TID_FRESH(); unsigned char* ws = kp->ws;
            float* outp = kp->out;
            const float* xin = (l == 0) ? kp->in[0] : outp;
            const float* pw = kp->in[2] + (size_t)l * DM;
            const float* pre1 = kp->in[1] + DM;
            const float* rowss = (const float*)(ws + OFF_CTL) + CW_ROWSS + l * S_;
            const bf16_t* MO = (const bf16_t*)(ws + OFF_MO); bf16_t* H = (bf16_t*)(ws + OFF_HY);
            f32x4 pwv[8], gv1[8];
#pragma unroll
            for (int j = 0; j < 8; ++j) { pwv[j] = *((const f32x4*)pw + lane + 64 * j); gv1[j] = *((const f32x4*)pre1 + lane + 64 * j); }
#pragma unroll 2
            for (int row = gw; row < S_; row += NGW) {
                const float sc = 1.0f / sqrtf(rowss[row] * (1.0f / DM) + NORM_EPS);
                const f32x4* xr = (const f32x4*)(xin + (size_t)row * DM) + lane; const u32x2* mr = (const u32x2*)(MO + (size_t)row * DM) + lane;
                f32x4* orow = (f32x4*)(outp + (size_t)row * DM) + lane;
                f32x4 v[8]; float s = 0.f;
#pragma unroll
                for (int j = 0; j < 8; ++j) { const f32x4 xv = xr[64 * j]; const u32x2 mw = mr[64 * j]; const f32x4 pv = pwv[j];
                    f32x4 o; o[0] = xv[0] + bflo(mw.x) * sc * pv[0]; o[1] = xv[1] + bfhi(mw.x) * sc * pv[1]; o[2] = xv[2] + bflo(mw.y) * sc * pv[2]; o[3] = xv[3] + bfhi(mw.y) * sc * pv[3];
                    orow[64 * j] = o; v[j] = o; s += (o[0] * o[0] + o[1] * o[1]) + (o[2] * o[2] + o[3] * o[3]); }
                if (l == 0) rms_row_store_g(v, wave_sum(s), gv1, H + (size_t)row * DM, lane);
            }
            if (l == 0) { __syncthreads(); convert_win(kp->in[3] + (size_t)DM * NIN, (bf16_t*)(ws + OFF_WIN), (LAS float*)(lds + wave * 16384), gw, NGW, lane); }
        }
#endif
        if (l == 0) GRID_BAR();
    }
}

extern "C" void kernel_launch(void* const* d_in, const int* in_sizes, int n_in, void* d_out, int out_size, void* d_ws, size_t ws_size, hipStream_t stream) {
    static int grid = 0;
    if (grid == 0) {
        if (n_in != 23 || out_size != S_ * DM || ws_size < WS_END) { fprintf(stderr, "kernel_launch: unexpected problem (n_in %d, out %d, ws %zu, need %zu)\n", n_in, out_size, ws_size, (size_t)WS_END); grid = -1; return; }
        int dev = 0, cus = 0, per_cu = 0;
        hipGetDevice(&dev);
        hipDeviceGetAttribute(&cus, hipDeviceAttributeMultiprocessorCount, dev);
        if (hipFuncSetAttribute((const void*)hybrid_fwd, hipFuncAttributeMaxDynamicSharedMemorySize, LDS_BYTES) != hipSuccess) { fprintf(stderr, "kernel_launch: hipFuncSetAttribute failed\n"); grid = -1; return; }
        hipOccupancyMaxActiveBlocksPerMultiprocessor(&per_cu, (const void*)hybrid_fwd, 512, LDS_BYTES);
        (void)hipGetLastError();
        if (per_cu < 1) per_cu = 1;
        grid = cus * per_cu;
        if (grid < N_RWKV_BLK + 8) { fprintf(stderr, "kernel_launch: grid %d too small\n", grid); grid = -1; return; }
    }
    if (grid < 0) return;
    Params p{};
    for (int i = 0; i < 23; ++i) p.in[i] = (const float*)d_in[i];
    p.out = (float*)d_out; p.ws = (unsigned char*)d_ws;
    void* args[] = {&p};
    hipError_t e = hipLaunchCooperativeKernel((const void*)hybrid_fwd, dim3(grid), dim3(512), args, LDS_BYTES, stream);
    if (e != hipSuccess) fprintf(stderr, "kernel_launch: cooperative launch failed: %s (grid %d)\n", hipGetErrorString(e), grid);
}
```
